# Optimizing an MI355X kernel written in HIP

```python
import jax, jax.numpy as jnp
from jax import lax
import numpy as np

D_MODEL = 1024
BATCH = 8
SEQ = 2048
DEPTH = 4

CHUNK = 64
HEAD_DIM = 64
RWKV_WIDTH = D_MODEL // 2
RWKV_HEADS = RWKV_WIDTH // HEAD_DIM
SC_WIDTH = D_MODEL // 4
SC_KERNEL = 3
CF_WIDTH = D_MODEL // 4
CF_KERNEL = 31
MIX_WIDTH = RWKV_WIDTH + SC_WIDTH + CF_WIDTH
IN_WIDTH = 3 * RWKV_WIDTH + 3 * SC_WIDTH + 2 * CF_WIDTH
DECAY_RANK = 64
ICLR_RANK = 64
GATE_RANK = 128
FFN_HIDDEN = ((8 * D_MODEL + 3 * 256 - 1) // (3 * 256)) * 256
NORM_EPS = 1e-6
LN_EPS = 1e-5
GN_EPS = 64e-5

kernel_name = "hymba_rwkv7_shortconv_conformer_trunk"


def rms_norm(x, g):
    x32 = x.astype(jnp.float32)
    y = x32 * lax.rsqrt(jnp.mean(x32 * x32, axis=-1, keepdims=True) + NORM_EPS)
    return (y * g.astype(jnp.float32)).astype(x.dtype)


def layer_norm(x, g, b):
    x32 = x.astype(jnp.float32)
    mu = jnp.mean(x32, axis=-1, keepdims=True)
    var = jnp.mean(jnp.square(x32 - mu), axis=-1, keepdims=True)
    y = (x32 - mu) * lax.rsqrt(var + LN_EPS)
    return (y * g.astype(jnp.float32) + b.astype(jnp.float32)).astype(x.dtype)


def token_shift(u):
    return jnp.pad(u[:, :-1], ((0, 0), (1, 0), (0, 0)))


def causal_dwconv(u, w):
    k_width, ch = w.shape
    return lax.conv_general_dilated(
        u, w[:, None, :].astype(u.dtype), window_strides=(1,), padding=[(k_width - 1, 0)],
        dimension_numbers=("NWC", "WIO", "NWC"), feature_group_count=ch)


def rwkv7_scan(r, w, k, v, a_vec, b_vec):
    xs = tuple(jnp.moveaxis(t, 1, 0) for t in (r, w, k, v, a_vec, b_vec))

    def step(S, inp):
        r_t, w_t, k_t, v_t, a_t, b_t = inp
        sa = jnp.einsum("bhij,bhj->bhi", S, a_t)
        S = S * w_t[:, :, None, :] + sa[..., None] * b_t[:, :, None, :] + v_t[..., None] * k_t[:, :, None, :]
        y = jnp.einsum("bhij,bhj->bhi", S, r_t)
        return S, y

    bsz, _, nh, nd = r.shape
    s0 = jnp.zeros((bsz, nh, nd, nd), jnp.float32)
    _, ys = lax.scan(step, s0, xs)
    return jnp.moveaxis(ys, 0, 1)


def rwkv7_group(h, rkv, mu_rkv, mu_wag, w0, w1, w2, a0, a1, a2, g1, g2, k_k, k_a, r_k, lnx_g, lnx_b):
    bsz, seq, _ = h.shape
    rkv = rkv + (token_shift(rkv) - rkv) * mu_rkv
    r, k, v = jnp.split(rkv, 3, axis=-1)
    dh = token_shift(h) - h
    xw = h + dh * mu_wag[0]
    xa = h + dh * mu_wag[1]
    xg = h + dh * mu_wag[2]
    w_log = -jax.nn.softplus(-(w0 + jnp.tanh(xw @ w1) @ w2).astype(jnp.float32)) - 0.5
    decay = jnp.exp(-jnp.exp(w_log))
    a = jax.nn.sigmoid((a0 + (xa @ a1) @ a2).astype(jnp.float32))
    g = jax.nn.sigmoid(xg @ g1) @ g2
    hs = lambda t: t.reshape(bsz, seq, RWKV_HEADS, HEAD_DIM)
    hp = lambda p: p.reshape(RWKV_HEADS, HEAD_DIM).astype(jnp.float32)
    r32, k32, v32 = (hs(t).astype(jnp.float32) for t in (r, k, v))
    a_h, w_h = hs(a), hs(decay)
    kk = k32 * hp(k_k)
    kk = kk / jnp.maximum(jnp.sqrt(jnp.sum(kk * kk, axis=-1, keepdims=True)), 1e-12)
    k32 = k32 * (1.0 + (a_h - 1.0) * hp(k_a))
    y = rwkv7_scan(r32, w_h, k32, v32, -kk, kk * a_h)
    mu = jnp.mean(y, axis=-1, keepdims=True)
    var = jnp.mean(jnp.square(y - mu), axis=-1, keepdims=True)
    y = (y - mu) * lax.rsqrt(var + GN_EPS)
    y = y * hp(lnx_g) + hp(lnx_b)
    bonus = jnp.sum(r32 * k32 * r_k.astype(jnp.float32), axis=-1, keepdims=True) * v32
    y = (y + bonus).reshape(bsz, seq, RWKV_WIDTH).astype(h.dtype)
    return y * g


def shortconv_group(sc_in, conv_w):
    gate_b, gate_c, u = jnp.split(sc_in, 3, axis=-1)
    return gate_b * causal_dwconv(gate_c * u, conv_w)


def conformer_group(cf_in, conv_w, conv_b, ln_g, ln_b):
    val, gate = jnp.split(cf_in, 2, axis=-1)
    u = val * jax.nn.sigmoid(gate)
    u = causal_dwconv(u, conv_w) + conv_b
    return jax.nn.silu(layer_norm(u, ln_g, ln_b))


def setup_inputs(seed: int = 0) -> dict:
    key = jax.random.key(seed)
    ks = iter(jax.random.split(key, 40))
    nrm = lambda shape, s: jax.random.normal(next(ks), shape, jnp.float32) * s
    unif = lambda shape: jax.random.uniform(next(ks), shape, jnp.float32)
    L = DEPTH
    return {
        "x": nrm((BATCH, SEQ, D_MODEL), 1.0),
        "w_in": nrm((L, D_MODEL, IN_WIDTH), D_MODEL ** -0.5),
        "mu_rkv": unif((L, 3 * RWKV_WIDTH)),
        "mu_wag": unif((L, 3, D_MODEL)),
        "w0": nrm((L, RWKV_WIDTH), 0.5),
        "w1": nrm((L, D_MODEL, DECAY_RANK), D_MODEL ** -0.5),
        "w2": nrm((L, DECAY_RANK, RWKV_WIDTH), 0.5 * DECAY_RANK ** -0.5),
        "a0": nrm((L, RWKV_WIDTH), 0.5),
        "a1": nrm((L, D_MODEL, ICLR_RANK), D_MODEL ** -0.5),
        "a2": nrm((L, ICLR_RANK, RWKV_WIDTH), 0.5 * ICLR_RANK ** -0.5),
        "g1": nrm((L, D_MODEL, GATE_RANK), D_MODEL ** -0.5),
        "g2": nrm((L, GATE_RANK, RWKV_WIDTH), GATE_RANK ** -0.5),
        "k_k": 0.85 + nrm((L, RWKV_WIDTH), 0.05),
        "k_a": 1.0 + nrm((L, RWKV_WIDTH), 0.05),
        "r_k": nrm((L, RWKV_HEADS, HEAD_DIM), 0.1),
        "lnx_g": 1.0 + nrm((L, RWKV_WIDTH), 0.05),
        "lnx_b": nrm((L, RWKV_WIDTH), 0.01),
        "sc_conv_w": nrm((L, SC_KERNEL, SC_WIDTH), SC_KERNEL ** -0.5),
        "cf_conv_w": nrm((L, CF_KERNEL, CF_WIDTH), CF_KERNEL ** -0.5),
        "cf_conv_b": nrm((L, CF_WIDTH), 0.01),
        "cf_ln_g": 1.0 + nrm((L, CF_WIDTH), 0.05),
        "cf_ln_b": nrm((L, CF_WIDTH), 0.01),
        "w_o": nrm((L, MIX_WIDTH, D_MODEL), MIX_WIDTH ** -0.5),
        "w_gate": nrm((L, D_MODEL, FFN_HIDDEN), D_MODEL ** -0.5),
        "w_up": nrm((L, D_MODEL, FFN_HIDDEN), D_MODEL ** -0.5),
        "w_down": nrm((L, FFN_HIDDEN, D_MODEL), FFN_HIDDEN ** -0.5),
        "pre_mix_g": 1.0 + nrm((L, D_MODEL), 0.05),
        "post_mix_g": 1.0 + nrm((L, D_MODEL), 0.05),
        "pre_ffn_g": 1.0 + nrm((L, D_MODEL), 0.05),
        "post_ffn_g": 1.0 + nrm((L, D_MODEL), 0.05),
    }


def reference(x, w_in, mu_rkv, mu_wag, w0, w1, w2, a0, a1, a2, g1, g2, k_k, k_a, r_k,
              lnx_g, lnx_b, sc_conv_w, cf_conv_w, cf_conv_b, cf_ln_g, cf_ln_b, w_o,
              w_gate, w_up, w_down, pre_mix_g, post_mix_g, pre_ffn_g, post_ffn_g):
    split_at = (3 * RWKV_WIDTH, 3 * RWKV_WIDTH + 3 * SC_WIDTH)
    for l in range(DEPTH):
        h = rms_norm(x, pre_mix_g[l])
        proj = h @ w_in[l]
        rkv, sc_in, cf_in = jnp.split(proj, split_at, axis=-1)
        y_rwkv = rwkv7_group(h, rkv, mu_rkv[l], mu_wag[l], w0[l], w1[l], w2[l], a0[l], a1[l], a2[l],
                             g1[l], g2[l], k_k[l], k_a[l], r_k[l], lnx_g[l], lnx_b[l])
        y_sc = shortconv_group(sc_in, sc_conv_w[l])
        y_cf = conformer_group(cf_in, cf_conv_w[l], cf_conv_b[l], cf_ln_g[l], cf_ln_b[l])
        mix = jnp.concatenate([y_rwkv, y_sc, y_cf], axis=-1) @ w_o[l]
        x = x + rms_norm(mix, post_mix_g[l])
        h2 = rms_norm(x, pre_ffn_g[l])
        f = (jax.nn.silu(h2 @ w_gate[l]) * (h2 @ w_up[l])) @ w_down[l]
        x = x + rms_norm(f, post_ffn_g[l])
    return x
```

```cpp
#include <hip/hip_runtime.h>
#include <cstdio>
#include <cstdint>
#ifndef DIAG
#define DIAG 0
#endif
namespace pg8 {
#define PG8_LAS __attribute__((address_space(3)))
typedef unsigned short bf16_t;
typedef short bf16x8 __attribute__((ext_vector_type(8)));
typedef float f32x4 __attribute__((ext_vector_type(4)));
typedef unsigned u32x4 __attribute__((ext_vector_type(4)));
constexpr int BM = 256, BK = 64, HALF = 128, HTB = HALF * BK * 2  , STAGE_BYTES = 8 * HTB, NXCD = 8, WGM = 8;

__host__ __device__ __forceinline__ int lds_byte(int r, int c) { const int st = (r >> 4) * 2 + (c >> 5), rr = r & 15, cc = c & 31, ob = rr * 64 + cc * 2; return st * 1024 + (ob ^ (((ob >> 9) & 1) << 5)); }
__host__ __device__ __forceinline__ void stage_rc(int b, int& R, int& C) { const int st = b / 1024, sb = b % 1024, swz = sb ^ (((sb >> 9) & 1) << 5); R = (st >> 1) * 16 + swz / 64; C = (st & 1) * 32 + (swz % 64) / 2; }
__host__ __device__ __forceinline__ int perm32(int rho) { const int n = rho >> 4, i = rho & 15; return 8 * (i >> 2) + 4 * n + (i & 3); }

struct Unit { int pm, pn; };
struct Gemm { const bf16_t* A; const bf16_t* Bt; int M, N, K; };

struct StaticOrder {
    int nM, nN, nwg, G, c;
    __host__ __device__ void init(int M, int N, int G_, int c_) { nM = M / BM; nN = N / BM; nwg = nM * nN; G = G_; c = c_; }
    __host__ __device__ bool next(int i, Unit& u) const {
        const long L = (long)i * G + c; if (L >= nwg) return false;
        int wgid = (int)L; { const int q = nwg / NXCD, r = nwg % NXCD, xcd = wgid % NXCD, off = wgid / NXCD; wgid = (xcd < r ? xcd * (q + 1) : r * (q + 1) + (xcd - r) * q) + off; }
        const int nig = WGM * nN, gid = wgid / nig, fm = gid * WGM, gsz = (nM - fm) < WGM ? (nM - fm) : WGM;
        u.pm = fm + ((wgid % nig) % gsz); u.pn = (wgid % nig) / gsz; return true;
    }
    __device__ __forceinline__ void a_ready(const Unit&) const {}
    __device__ __forceinline__ void done(const Unit&) const {}
};

__device__ __forceinline__ unsigned cvt_pk_bf16(float lo, float hi) { unsigned r; asm volatile("v_cvt_pk_bf16_f32 %0, %1, %2" : "=v"(r) : "v"(lo), "v"(hi)); return r; }
typedef float f32x2 __attribute__((ext_vector_type(2)));
struct EpiBf16 {
    static constexpr bool PERM = true, AFTER_DRAIN = false;
    bf16_t* O; int ldc;
    __device__ __forceinline__ void operator()(const f32x4 (&acc)[2][2][4][2], const Unit& u, int wr, int wc, int fr, int fq) const {
        const int row0 = u.pm * BM + wr * 64 + fr, col0 = u.pn * BM + wc * 32 + 8 * fq;
#pragma unroll
        for (int ai = 0; ai < 2; ++ai)
#pragma unroll
            for (int m = 0; m < 4; ++m) { bf16_t* rowp = O + (size_t)(row0 + ai * HALF + m * 16) * ldc + col0;
#pragma unroll
                for (int bj = 0; bj < 2; ++bj) { const f32x4 v0 = acc[ai][bj][m][0], v1 = acc[ai][bj][m][1];
                    u32x4 w; w.x = cvt_pk_bf16(v0[0], v0[1]); w.y = cvt_pk_bf16(v0[2], v0[3]); w.z = cvt_pk_bf16(v1[0], v1[1]); w.w = cvt_pk_bf16(v1[2], v1[3]);
                    *(u32x4*)(rowp + bj * HALF) = w; } }
    }
};
struct EpiF32 {
    static constexpr bool PERM = false, AFTER_DRAIN = false;
    float* C; int ldc;
    __device__ __forceinline__ void operator()(const f32x4 (&acc)[2][2][4][2], const Unit& u, int wr, int wc, int fr, int fq) const {
        const int row0 = u.pm * BM + wr * 64 + fr, col0 = u.pn * BM + wc * 32 + 4 * fq;
#pragma unroll
        for (int ai = 0; ai < 2; ++ai)
#pragma unroll
            for (int m = 0; m < 4; ++m) { float* rowp = C + (size_t)(row0 + ai * HALF + m * 16) * ldc + col0;
#pragma unroll
                for (int bj = 0; bj < 2; ++bj)
#pragma unroll
                    for (int n = 0; n < 2; ++n) *(f32x4*)(rowp + bj * HALF + n * 16) = acc[ai][bj][m][n]; }
    }
};
struct EpiSwiGLU {
    static constexpr bool PERM = true, AFTER_DRAIN = false;
    bf16_t* O; int ldc;
    __device__ __forceinline__ void operator()(const f32x4 (&acc)[2][2][4][2], const Unit& u, int wr, int wc, int fr, int fq) const {
        const int row0 = u.pm * BM + wr * 64 + fr, col0 = u.pn * HALF + wc * 32 + 8 * fq;
#pragma unroll
        for (int ai = 0; ai < 2; ++ai)
#pragma unroll
            for (int m = 0; m < 4; ++m) { bf16_t* rowp = O + (size_t)(row0 + ai * HALF + m * 16) * ldc + col0;
                float o[8];
#pragma unroll
                for (int n = 0; n < 2; ++n)
#pragma unroll
                    for (int e = 0; e < 4; ++e) { const float g = acc[ai][0][m][n][e], up = acc[ai][1][m][n][e];
                        o[n * 4 + e] = g * __builtin_amdgcn_rcpf(1.0f + __builtin_amdgcn_exp2f(-1.44269504089f * g)) * up; }
                u32x4 w; w.x = cvt_pk_bf16(o[0], o[1]); w.y = cvt_pk_bf16(o[2], o[3]); w.z = cvt_pk_bf16(o[4], o[5]); w.w = cvt_pk_bf16(o[6], o[7]);
                *(u32x4*)rowp = w; }
    }
};

template <class Epi, class Sched, bool ALIGN_EPI = false, bool SP2 = false>
__device__ __forceinline__ void gemm_phase(PG8_LAS unsigned char* lds, const Gemm g, const Sched& S, const Epi& E) {
    int tid_l = threadIdx.x; asm volatile("" : "+v"(tid_l));
    const int tid = tid_l, wid = __builtin_amdgcn_readfirstlane(tid >> 6), lane = tid & 63, wr = wid >> 2, wc = wid & 3, fr = lane & 15, fq = lane >> 4;
    const int K = g.K, nt = K / BK;
    unsigned voffA[2], voffB[2];
#pragma unroll
    for (int i = 0; i < 2; ++i) { int R, C; stage_rc(tid * 16 + i * 8192, R, C); const int Rb = Epi::PERM ? ((R & ~31) + perm32(R & 31)) : R;
        voffA[i] = (unsigned)(R * K + C) * 2u; voffB[i] = (unsigned)(Rb * K + C) * 2u; }
    const size_t kstep = (size_t)(BK * 2);
    const size_t hstep = (size_t)HALF * K * 2;
    const size_t tstep = 2 * hstep;
    const unsigned ldsw = (unsigned)wid * 1024u;
    const int aoff = lds_byte(wr * 64 + fr, fq * 8), boff = lds_byte(wc * 32 + fr, fq * 8);
#define PG8_SA(b, h) (((b) * 2 + (h)) * HTB)
#define PG8_SB(b, h) ((4 + (b) * 2 + (h)) * HTB)
#define PG8_STAGE(bufoff, gbase, voff) do { _Pragma("unroll") for (int _i = 0; _i < 2; ++_i) \
        __builtin_amdgcn_global_load_lds((const unsigned*)((const char*)(gbase) + (voff)[_i]), (PG8_LAS unsigned*)(lds + (bufoff) + ldsw + _i * 8192), 16, 0, 0); } while (0)
#define PG8_LDA(dst, b, h) do { _Pragma("unroll") for (int m = 0; m < 4; ++m) _Pragma("unroll") for (int k = 0; k < 2; ++k) dst[m][k] = *(const PG8_LAS bf16x8*)(lds + PG8_SA(b, h) + aoff + m * 2048 + k * 1024); } while (0)
#define PG8_LDB(dst, b, h) do { _Pragma("unroll") for (int n = 0; n < 2; ++n) _Pragma("unroll") for (int k = 0; k < 2; ++k) dst[n][k] = *(const PG8_LAS bf16x8*)(lds + PG8_SB(b, h) + boff + n * 2048 + k * 1024); } while (0)
#define PG8_MMA(ai, bj, At, Bt) do { __builtin_amdgcn_s_setprio(1); _Pragma("unroll") for (int m = 0; m < 4; ++m) _Pragma("unroll") for (int n = 0; n < 2; ++n) _Pragma("unroll") for (int k = 0; k < 2; ++k) \
        acc[ai][bj][m][n] = __builtin_amdgcn_mfma_f32_16x16x32_bf16(Bt[n][k], At[m][k], acc[ai][bj][m][n], 0, 0, 0); __builtin_amdgcn_s_setprio(0); } while (0)
#define PG8_WAIT_V(n) asm volatile("s_waitcnt vmcnt(" #n ")" ::: "memory")
#define PG8_WAIT_L(n) asm volatile("s_waitcnt lgkmcnt(" #n ")" ::: "memory")
#define PG8_BAR __builtin_amdgcn_s_barrier()
#define PG8_SCHED __builtin_amdgcn_sched_barrier(0)
    Unit cur, nxt; int ui = 0;
    if (!S.next(0, cur)) return;
    f32x4 acc[2][2][4][2];
#pragma unroll
    for (int a = 0; a < 2; ++a)
#pragma unroll
        for (int b = 0; b < 2; ++b)
#pragma unroll
            for (int m = 0; m < 4; ++m)
#pragma unroll
                for (int n = 0; n < 2; ++n) acc[a][b][m][n] = (f32x4){0.f, 0.f, 0.f, 0.f};
    bf16x8 At[4][2], B0[2][2], B1[2][2];
    const char* cA = (const char*)g.A + (size_t)cur.pm * tstep; const char* cB = (const char*)g.Bt + (size_t)cur.pn * tstep;
    S.a_ready(cur);
    if constexpr (SP2) {
        PG8_STAGE(PG8_SB(0, 0), cB, voffB); PG8_STAGE(PG8_SB(0, 1), cB + hstep, voffB); PG8_STAGE(PG8_SA(0, 0), cA, voffA); PG8_STAGE(PG8_SA(0, 1), cA + hstep, voffA);
        if (wr == 1) PG8_BAR;
        PG8_WAIT_V(2); PG8_BAR;
        PG8_STAGE(PG8_SB(1, 0), cB + kstep, voffB); PG8_STAGE(PG8_SA(1, 0), cA + kstep, voffA); PG8_STAGE(PG8_SB(1, 1), cB + hstep + kstep, voffB);
        PG8_WAIT_V(6); PG8_BAR;
    } else {
        PG8_STAGE(PG8_SB(0, 0), cB, voffB); PG8_STAGE(PG8_SA(0, 0), cA, voffA); PG8_STAGE(PG8_SB(0, 1), cB + hstep, voffB); PG8_STAGE(PG8_SA(0, 1), cA + hstep, voffA);
        if (wr == 1) PG8_BAR;
        PG8_WAIT_V(4); PG8_BAR;
        PG8_STAGE(PG8_SB(1, 0), cB + kstep, voffB); PG8_STAGE(PG8_SA(1, 0), cA + kstep, voffA); PG8_STAGE(PG8_SB(1, 1), cB + hstep + kstep, voffB);
        PG8_WAIT_V(6); PG8_BAR;
    }
    for (;;) {
        const bool has_next = S.next(ui + 1, nxt);
        const char* nA = has_next ? (const char*)g.A + (size_t)nxt.pm * tstep : cA; const char* nB = has_next ? (const char*)g.Bt + (size_t)nxt.pn * tstep : cB;
        for (int t = 0; t < nt; t += 2) {
            const bool last = (t == nt - 2);
            const char* a1 = cA + (size_t)(t + 1) * kstep;
            const char* a2 = last ? nA : cA + (size_t)(t + 2) * kstep; const char* b2 = last ? nB : cB + (size_t)(t + 2) * kstep;
            const char* a3 = a2 + kstep; const char* b3 = b2 + kstep;
            if (last && has_next) S.a_ready(nxt);
            if constexpr (SP2) {
            PG8_LDB(B0, 0, 0); PG8_LDB(B1, 0, 1); PG8_SCHED; PG8_LDA(At, 0, 0); PG8_STAGE(PG8_SA(1, 1), a1 + hstep, voffA);
            PG8_WAIT_V(8); PG8_WAIT_L(0); PG8_BAR; PG8_MMA(0, 0, At, B0); PG8_MMA(0, 1, At, B1); PG8_BAR; PG8_SCHED;
            PG8_LDA(At, 0, 1); PG8_STAGE(PG8_SB(0, 0), b2, voffB); PG8_STAGE(PG8_SB(0, 1), b2 + hstep, voffB); PG8_STAGE(PG8_SA(0, 0), a2, voffA);
            PG8_WAIT_V(8); PG8_WAIT_L(0); PG8_BAR; PG8_MMA(1, 0, At, B0); PG8_MMA(1, 1, At, B1); PG8_BAR; PG8_SCHED;
            PG8_LDB(B0, 1, 0); PG8_LDB(B1, 1, 1); PG8_SCHED; PG8_LDA(At, 1, 0); PG8_STAGE(PG8_SA(0, 1), a2 + hstep, voffA);
            PG8_WAIT_V(8); PG8_WAIT_L(0); PG8_BAR; PG8_MMA(0, 0, At, B0); PG8_MMA(0, 1, At, B1); PG8_BAR; PG8_SCHED;
            PG8_LDA(At, 1, 1); PG8_STAGE(PG8_SB(1, 0), b3, voffB); PG8_STAGE(PG8_SB(1, 1), b3 + hstep, voffB); PG8_STAGE(PG8_SA(1, 0), a3, voffA);
            PG8_WAIT_V(8); PG8_WAIT_L(0); PG8_BAR; PG8_MMA(1, 0, At, B0); PG8_MMA(1, 1, At, B1); PG8_BAR; PG8_SCHED;
            } else {
            PG8_LDB(B0, 0, 0); PG8_SCHED; PG8_LDA(At, 0, 0); PG8_STAGE(PG8_SA(1, 1), a1 + hstep, voffA);
            PG8_WAIT_L(8); PG8_BAR; PG8_WAIT_L(0); PG8_MMA(0, 0, At, B0); PG8_BAR; PG8_SCHED;
            PG8_LDB(B1, 0, 1); PG8_STAGE(PG8_SB(0, 0), b2, voffB);
            PG8_BAR; PG8_WAIT_L(0); PG8_MMA(0, 1, At, B1); PG8_BAR;
            PG8_LDA(At, 0, 1); PG8_STAGE(PG8_SA(0, 0), a2, voffA);
            PG8_BAR; PG8_WAIT_L(0); PG8_MMA(1, 0, At, B0); PG8_BAR; PG8_SCHED;
            PG8_STAGE(PG8_SB(0, 1), b2 + hstep, voffB);
            PG8_WAIT_V(6); PG8_BAR; PG8_MMA(1, 1, At, B1); PG8_BAR;
            PG8_LDB(B0, 1, 0); PG8_SCHED; PG8_LDA(At, 1, 0); PG8_STAGE(PG8_SA(0, 1), a2 + hstep, voffA);
            PG8_WAIT_L(8); PG8_BAR; PG8_WAIT_L(0); PG8_MMA(0, 0, At, B0); PG8_BAR; PG8_SCHED;
            PG8_LDB(B1, 1, 1); PG8_STAGE(PG8_SB(1, 0), b3, voffB);
            PG8_BAR; PG8_WAIT_L(0); PG8_MMA(0, 1, At, B1); PG8_BAR;
            PG8_LDA(At, 1, 1); PG8_STAGE(PG8_SA(1, 0), a3, voffA);
            PG8_BAR; PG8_WAIT_L(0); PG8_MMA(1, 0, At, B0); PG8_BAR; PG8_SCHED;
            PG8_STAGE(PG8_SB(1, 1), b3 + hstep, voffB);
            PG8_WAIT_V(6); PG8_BAR; PG8_MMA(1, 1, At, B1); PG8_BAR;
            }
        }
        if constexpr (ALIGN_EPI) { if (wr == 0) PG8_BAR; }
        if constexpr (!Epi::AFTER_DRAIN) { E(acc, cur, wr, wc, fr, fq); S.done(cur); }
        if (!has_next) break;
#pragma unroll
        for (int a = 0; a < 2; ++a)
#pragma unroll
            for (int b = 0; b < 2; ++b)
#pragma unroll
                for (int m = 0; m < 4; ++m)
#pragma unroll
                    for (int n = 0; n < 2; ++n) acc[a][b][m][n] = (f32x4){0.f, 0.f, 0.f, 0.f};
        cur = nxt; cA = nA; cB = nB; ++ui;
        if constexpr (ALIGN_EPI) { if (wr == 1) PG8_BAR; }
    }
    PG8_WAIT_V(0);
    if constexpr (!ALIGN_EPI) { if (wr == 0) PG8_BAR; }
    PG8_BAR;
    if constexpr (Epi::AFTER_DRAIN) { E.fused(acc, cur, wr, wc, fr, fq, lds, wid, lane); S.done(cur); }
#undef PG8_SA
#undef PG8_SB
#undef PG8_STAGE
#undef PG8_LDA
#undef PG8_LDB
#undef PG8_MMA
#undef PG8_WAIT_V
#undef PG8_WAIT_L
#undef PG8_BAR
#undef PG8_SCHED
}
}

constexpr int NWAVES = 8, NTHR = 512;
constexpr int NB = 8, NT = 2048, DM = 1024, M = NB * NT, NL = 4;
constexpr int RW = 512, NH = 8, INW = 2816, NP = 3328, FF = 2816, NGU = 2 * FF;
constexpr int C_R = 0, C_K = 512, C_V = 1024, C_SCB = 1536, C_SCC = 1792, C_SCU = 2048, C_CFV = 2304, C_CFG = 2560;
constexpr int C_PW = 2816, C_PA = 2880, C_PG = 2944, C_QW = 3072, C_QA = 3136, C_QG = 3200;
constexpr float NORM_EPS = 1e-6f, LN_EPS = 1e-5f, GN_EPS = 64e-5f;

enum { I_X = 0, I_WIN, I_MURKV, I_MUWAG, I_W0, I_W1, I_W2, I_A0, I_A1, I_A2, I_G1, I_G2, I_KK, I_KA, I_RK, I_LNXG, I_LNXB, I_SCW, I_CFW, I_CFB, I_CFLG, I_CFLB,
       I_WO, I_WGATE, I_WUP, I_WDOWN, I_PREMIX, I_POSTMIX, I_PREFFN, I_POSTFFN, N_IN };

constexpr size_t MiB = 1u << 20;
constexpr size_t WS_CTL = 0, CTL_ZERO_BYTES = 64 * 1024;
constexpr size_t WS_WIN = 1 * MiB;
constexpr size_t WS_WO = WS_WIN + (size_t)NP * DM * 2;
constexpr size_t WS_WGU = WS_WO + (size_t)DM * DM * 2;
constexpr size_t WS_WDN = WS_WGU + (size_t)NGU * DM * 2;
constexpr size_t WS_HA = 27 * MiB;
constexpr size_t WS_HB = 59 * MiB;
constexpr size_t WS_PROJ = 91 * MiB;
constexpr size_t WS_X1 = 195 * MiB;
constexpr size_t WS_BON = 259 * MiB;
constexpr size_t WS_END = WS_BON + (size_t)M * 8 * 4;
static_assert(WS_WDN + (size_t)DM * FF * 2 <= WS_HA, "weights fit");
static_assert(WS_PROJ + (size_t)M * NP * 2 <= WS_X1, "proj fits");

#define GAS __attribute__((address_space(1)))
#define LAS __attribute__((address_space(3)))
typedef unsigned short bf16;
typedef unsigned v4u __attribute__((ext_vector_type(4)));
typedef unsigned v2u __attribute__((ext_vector_type(2)));
typedef float f32x4 __attribute__((ext_vector_type(4)));
typedef GAS unsigned gu32;
#define LDS_WAIT() asm volatile("s_waitcnt lgkmcnt(0)" ::: "memory")

__device__ __forceinline__ unsigned f2bf(float f) { unsigned u = __builtin_bit_cast(unsigned, f); return (u + 0x7fffu + ((u >> 16) & 1u)) >> 16; }
__device__ __forceinline__ unsigned pk2(float lo, float hi) { return f2bf(lo) | (f2bf(hi) << 16); }
__device__ __forceinline__ float bf2f(unsigned short u) { return __builtin_bit_cast(float, (unsigned)u << 16); }
__device__ __forceinline__ float bflo(unsigned u) { return __builtin_bit_cast(float, u << 16); }
__device__ __forceinline__ float bfhi(unsigned u) { return __builtin_bit_cast(float, u & 0xffff0000u); }
__device__ __forceinline__ float sigmoidf_(float x) { return 1.0f / (1.0f + __expf(-x)); }

__device__ __forceinline__ float wave_sum(float v) {
#pragma unroll
    for (int o = 1; o < 64; o <<= 1) v += __shfl_xor(v, o);
    return v;
}
template <int CTRL> __device__ __forceinline__ float dpp_mov(float x) { return __builtin_bit_cast(float, __builtin_amdgcn_update_dpp(0, __builtin_bit_cast(int, x), CTRL, 0xf, 0xf, true)); }
__device__ __forceinline__ float allreduce16(float x) {
    x += dpp_mov<0xB1>(x);
    x += dpp_mov<0x4E>(x);
    x += dpp_mov<0x141>(x);
    x += dpp_mov<0x140>(x);
    return x;
}

#define XB_TMO      128
#define XB_XCNT(j)  (256  + 64 * (j))
#define XB_XSUB(j)  (1280 + 64 * (j))
#define XB_XGEN(j)  (2304 + 64 * (j))
#define XB_TOP      3328
#define XB_TOPGEN   3392
#define XCD_BAR_WORDS 3456
#define XB_SPIN_CAP (1u << 18)
__device__ __forceinline__ unsigned xb_ld(unsigned* p)              { return __hip_atomic_load(p, __ATOMIC_RELAXED, __HIP_MEMORY_SCOPE_AGENT); }
__device__ __forceinline__ unsigned xb_add(unsigned* p, unsigned v) { return __hip_atomic_fetch_add(p, v, __ATOMIC_RELAXED, __HIP_MEMORY_SCOPE_AGENT); }
__device__ __forceinline__ unsigned xb_xcc_id() { return (unsigned)__builtin_amdgcn_s_getreg((3 << 11) | 20) & 0xFu; }
#define XB_SPIN(cond, bar) do { unsigned _sp = 0; while (cond) { __builtin_amdgcn_s_sleep(1); \
    if ((++_sp & 255u) == 0u) { if (xb_ld(&(bar)[XB_TMO])) break; if (_sp > XB_SPIN_CAP) { atomicAdd(&(bar)[XB_TMO], 1u); break; } } } } while (0)
struct XcdBarrier { unsigned* bar; unsigned x; volatile LAS unsigned* st; };
__device__ __forceinline__ XcdBarrier xcd_barrier_post(unsigned* bar, volatile LAS unsigned* st) {
    XcdBarrier b; b.bar = bar; b.x = xb_xcc_id(); b.st = st;
    if (threadIdx.x == 0) (void)xb_add(&bar[XB_XCNT(b.x)], 1u);
    return b;
}
__device__ __forceinline__ void xcd_barrier_complete(unsigned* bar, unsigned x, unsigned& nloc, unsigned& nx) {
    const unsigned G = gridDim.x * gridDim.y * gridDim.z;
    unsigned sum, cnt, mine, sp = 0u;
    for (;;) {
        sum = 0u; cnt = 0u; mine = 0u;
#pragma unroll
        for (unsigned j = 0; j < 16; ++j) { const unsigned c = xb_ld(&bar[XB_XCNT(j)]); sum += c; cnt += (c > 0u) ? 1u : 0u; mine = (j == x) ? c : mine; }
        if (sum == G) break;
        __builtin_amdgcn_s_sleep(1);
        if ((++sp & 255u) == 0u) { if (xb_ld(&bar[XB_TMO])) break; if (sp > XB_SPIN_CAP) { atomicAdd(&bar[XB_TMO], 1u); break; } }
    }
    nloc = mine > 0u ? mine : 1u; nx = cnt > 0u ? cnt : 1u;
}
__device__ __forceinline__ void xcd_barrier(const XcdBarrier& b) {
    asm volatile("s_waitcnt vmcnt(0)" ::: "memory");
    __syncthreads();
    if (threadIdx.x == 0) {
        unsigned* bar = b.bar;
        __builtin_amdgcn_s_waitcnt(0);
        unsigned nloc = b.st[0], nx = b.st[1];
        if (nloc == 0u) { xcd_barrier_complete(bar, b.x, nloc, nx); b.st[0] = nloc; b.st[1] = nx; }
        const unsigned old = xb_add(&bar[XB_XSUB(b.x)], 1u);
        const unsigned gen = old / nloc;
        if (old + 1u == (gen + 1u) * nloc) {
            __builtin_amdgcn_fence(__ATOMIC_RELEASE, "agent");
            asm volatile("s_waitcnt vmcnt(0)" ::: "memory");
            const unsigned og = xb_add(&bar[XB_TOP], 1u);
            const unsigned tg = og / nx;
            if (og + 1u == (tg + 1u) * nx) xb_add(&bar[XB_TOPGEN], 1u);
            else XB_SPIN(xb_ld(&bar[XB_TOPGEN]) == tg, bar);
            __builtin_amdgcn_fence(__ATOMIC_ACQUIRE, "agent");
            xb_add(&bar[XB_XGEN(b.x)], 1u);
            asm volatile("s_waitcnt vmcnt(0)" ::: "memory");
        } else {
            XB_SPIN(xb_ld(&bar[XB_XGEN(b.x)]) == gen, bar);
            __builtin_amdgcn_fence(__ATOMIC_ACQUIRE, "agent");
            asm volatile("s_waitcnt vmcnt(0)" ::: "memory");
        }
    }
    __syncthreads();
}

constexpr int RING_BYTES = 131072, MISC_OFF = RING_BYTES + 320, LDS_BYTES = 147456;

struct Args { const float* in[N_IN]; float* out; unsigned char* ws; int ph_lo, ph_hi; };

struct Frame {
    LAS unsigned char* lds;
    int tid, lane, wave, blk, G;
    const float* const* in; float* out; unsigned char* ws;
};

__device__ __forceinline__ void transpose_item(const float* W, int K, int N, bf16* WT, int dst_row0, int k0, int n0, const float* s, int mode, LAS float* scr, int lane) {
#pragma unroll 8
    for (int i = 0; i < 32; ++i) { const int kk = 2 * i + (lane >> 5); float v = W[(size_t)(k0 + kk) * N + n0 + (lane & 31)];
        if (mode) { const float sv = s[k0 + kk]; v *= (mode == 1) ? sv : (1.0f - sv); }
        scr[kk * 33 + (lane & 31)] = v; }
    LDS_WAIT(); asm volatile("" ::: "memory");
    const int c = lane & 7;
#pragma unroll
    for (int j = 0; j < 4; ++j) { const int n = (lane >> 3) + 8 * j; const LAS float* p = scr + (8 * c) * 33 + n;
        v4u o; o.x = pk2(p[0 * 33], p[1 * 33]); o.y = pk2(p[2 * 33], p[3 * 33]); o.z = pk2(p[4 * 33], p[5 * 33]); o.w = pk2(p[6 * 33], p[7 * 33]);
        *(GAS v4u*)(WT + (size_t)(dst_row0 + n) * K + k0 + 8 * c) = o; }
    LDS_WAIT(); asm volatile("" ::: "memory");
}
__device__ __forceinline__ void phase_conv(const Frame& F, int l) {
    LAS float* scr = (LAS float*)(F.lds + F.wave * 16384);
    const int gw = F.blk * NWAVES + F.wave, NGW = F.G * NWAVES;
    bf16* WIN = (bf16*)(F.ws + WS_WIN); bf16* WO = (bf16*)(F.ws + WS_WO); bf16* WGU = (bf16*)(F.ws + WS_WGU); bf16* WDN = (bf16*)(F.ws + WS_WDN);
    constexpr int I_IN = 16 * 88, I_LORA = 256, I_O = 16 * 32, I_G = 16 * 88, I_D = 44 * 32;
    constexpr int NITEMS = I_IN + I_LORA + I_O + 2 * I_G + I_D;
    const float* mu = F.in[I_MUWAG] + (size_t)l * 3 * DM;
    for (int it = gw; it < NITEMS; it += NGW) {
        int r = it;
        if (r < I_IN) { const int kb = r / 88, nb = r % 88; transpose_item(F.in[I_WIN] + (size_t)l * DM * INW, DM, INW, WIN, 32 * nb, 64 * kb, 32 * nb, nullptr, 0, scr, F.lane); continue; } r -= I_IN;
        if (r < I_LORA) {
            int sub, rr;
            if (r < 128) { sub = r / 32; rr = r % 32; } else { sub = 4 + (r - 128) / 64; rr = (r - 128) % 64; }
            const int which = sub >> 1, isq = sub & 1, Nn = (which == 2) ? 128 : 64, nblk = Nn / 32, kb = rr / nblk, nb = rr % nblk;
            const float* W = (which == 0 ? F.in[I_W1] : which == 1 ? F.in[I_A1] : F.in[I_G1]) + (size_t)l * DM * Nn;
            const int dst = (which == 0 ? (isq ? C_QW : C_PW) : which == 1 ? (isq ? C_QA : C_PA) : (isq ? C_QG : C_PG)) + 32 * nb;
            transpose_item(W, DM, Nn, WIN, dst, 64 * kb, 32 * nb, mu + which * DM, isq ? 1 : 2, scr, F.lane); continue; } r -= I_LORA;
        if (r < I_O) { const int kb = r / 32, nb = r % 32; transpose_item(F.in[I_WO] + (size_t)l * DM * DM, DM, DM, WO, 32 * nb, 64 * kb, 32 * nb, nullptr, 0, scr, F.lane); continue; } r -= I_O;
        if (r < 2 * I_G) { const int up = r / I_G, q = r % I_G, kb = q / 88, nb = q % 88, n0 = 32 * nb;
            const float* W = (up ? F.in[I_WUP] : F.in[I_WGATE]) + (size_t)l * DM * FF;
            transpose_item(W, DM, FF, WGU, (n0 / 128) * 256 + (n0 % 128) + up * 128, 64 * kb, n0, nullptr, 0, scr, F.lane); continue; } r -= 2 * I_G;
        { const int kb = r / 32, nb = r % 32; transpose_item(F.in[I_WDOWN] + (size_t)l * FF * DM, FF, DM, WDN, 32 * nb, 64 * kb, 32 * nb, nullptr, 0, scr, F.lane); }
    }
}

__device__ __forceinline__ void store_row_bf16(bf16* orow, const f32x4 (&v)[4], float r, const float* g, int lane) {
    GAS unsigned long long* o8 = (GAS unsigned long long*)orow + lane;
#pragma unroll
    for (int j = 0; j < 4; ++j) { const f32x4 gg = *(const f32x4*)(g + 4 * lane + 256 * j);
        o8[64 * j] = (unsigned long long)pk2(v[j].x * r * gg.x, v[j].y * r * gg.y) | ((unsigned long long)pk2(v[j].z * r * gg.z, v[j].w * r * gg.w) << 32); }
}
__device__ __forceinline__ float row_sumsq(const f32x4 (&v)[4]) {
    float s = 0.f;
#pragma unroll
    for (int j = 0; j < 4; ++j) s += (v[j].x * v[j].x + v[j].y * v[j].y) + (v[j].z * v[j].z + v[j].w * v[j].w);
    return wave_sum(s);
}
__device__ __forceinline__ void phase_norm0(const Frame& F) {
    const int gw = F.blk * NWAVES + F.wave, NGW = F.G * NWAVES;
    bf16* H = (bf16*)(F.ws + WS_HA); const float* g = F.in[I_PREMIX];
    for (int m = gw; m < M; m += NGW) {
        const GAS f32x4* xr = (const GAS f32x4*)(F.in[I_X] + (size_t)m * DM) + F.lane;
        f32x4 v[4];
#pragma unroll
        for (int j = 0; j < 4; ++j) v[j] = xr[64 * j];
        const float r = rsqrtf(row_sumsq(v) * (1.f / DM) + NORM_EPS);
        store_row_bf16(H + (size_t)m * DM, v, r, g, F.lane);
    }
}
__device__ __forceinline__ void phase_norm_res(const Frame& F, const float* tmp, const float* xold, const float* g1, const float* g2) {
    const int gw = F.blk * NWAVES + F.wave, NGW = F.G * NWAVES;
    bf16* H = (bf16*)(F.ws + WS_HA);
    for (int m = gw; m < M; m += NGW) {
        const GAS f32x4* tr = (const GAS f32x4*)(tmp + (size_t)m * DM) + F.lane;
        const GAS f32x4* xr = (const GAS f32x4*)(xold + (size_t)m * DM) + F.lane;
        GAS f32x4* orow = (GAS f32x4*)(F.out + (size_t)m * DM) + F.lane;
        f32x4 v[4], x[4];
#pragma unroll
        for (int j = 0; j < 4; ++j) { v[j] = tr[64 * j]; x[j] = xr[64 * j]; }
        const float r = rsqrtf(row_sumsq(v) * (1.f / DM) + NORM_EPS);
#pragma unroll
        for (int j = 0; j < 4; ++j) { const f32x4 gg = *(const f32x4*)(g1 + 4 * F.lane + 256 * j); x[j] = x[j] + v[j] * r * gg; orow[64 * j] = x[j]; }
        if (g2) { const float r2 = rsqrtf(row_sumsq(x) * (1.f / DM) + NORM_EPS); store_row_bf16(H + (size_t)m * DM, x, r2, g2, F.lane); }
    }
}

__device__ __forceinline__ void phase_prep(const Frame& F, int l) {
    LAS float* lin = (LAS float*)F.lds;
    const int c = F.tid, hh = F.wave;
    const bf16* PROJ = (const bf16*)(F.ws + WS_PROJ);
    _Float16* LW = (_Float16*)(F.ws + WS_X1); bf16* KP = (bf16*)(F.ws + WS_X1 + 16 * MiB); bf16* KK = (bf16*)(F.ws + WS_X1 + 32 * MiB); bf16* BV = (bf16*)(F.ws + WS_X1 + 48 * MiB);
    bf16* RR = (bf16*)(F.ws + WS_HA + 16 * MiB); float* BON = (float*)(F.ws + WS_BON);
    const float w0c = F.in[I_W0][l * RW + c], a0c = F.in[I_A0][l * RW + c], kkc = F.in[I_KK][l * RW + c], kac = F.in[I_KA][l * RW + c], rkc = F.in[I_RK][l * RW + c];
    const float mur = F.in[I_MURKV][l * 3 * RW + c], muk = F.in[I_MURKV][l * 3 * RW + RW + c];
    float W2r[64], A2r[64];
#pragma unroll
    for (int j = 0; j < 64; ++j) { W2r[j] = F.in[I_W2][((size_t)l * 64 + j) * RW + c]; A2r[j] = F.in[I_A2][((size_t)l * 64 + j) * RW + c]; }
    for (int tile = F.blk; tile < M / 64; tile += F.G) {
        const int m0 = tile * 64;
        float rprev = 0.f, kprev = 0.f;
        if ((m0 % NT) != 0) { rprev = bf2f(PROJ[(size_t)(m0 - 1) * NP + C_R + c]); kprev = bf2f(PROJ[(size_t)(m0 - 1) * NP + C_K + c]); }
        for (int i = 0; i < 64; ++i) {
            const int m = m0 + i, t = m % NT, buf = (i & 1) * 128;
            if (c < 128) { const int j = c & 63, which = c >> 6;
                const float p = bf2f(PROJ[(size_t)m * NP + (which ? C_PA : C_PW) + j]);
                const float q = t > 0 ? bf2f(PROJ[(size_t)(m - 1) * NP + (which ? C_QA : C_QW) + j]) : 0.f;
                lin[buf + c] = which ? (p + q) : tanhf(p + q); }
            const float rp = bf2f(PROJ[(size_t)m * NP + C_R + c]), kp_ = bf2f(PROJ[(size_t)m * NP + C_K + c]);
            __syncthreads();
            float wp = w0c, ap = a0c;
#pragma unroll
            for (int j = 0; j < 64; j += 4) { const f32x4 lw4 = *(const LAS f32x4*)(lin + buf + j), la4 = *(const LAS f32x4*)(lin + buf + 64 + j);
                wp += lw4.x * W2r[j] + lw4.y * W2r[j + 1] + lw4.z * W2r[j + 2] + lw4.w * W2r[j + 3];
                ap += la4.x * A2r[j] + la4.y * A2r[j + 1] + la4.z * A2r[j + 2] + la4.w * A2r[j + 3]; }
            const float a = sigmoidf_(ap), lwv = -0.60653065971f * sigmoidf_(wp);
            const float r = rp + (rprev - rp) * mur, k = kp_ + (kprev - kp_) * muk;
            rprev = rp; kprev = kp_;
            const float kku = k * kkc, n2 = wave_sum(kku * kku);
            const float kk = kku / fmaxf(sqrtf(n2), 1e-12f);
            const float kpr = k * (1.0f + (a - 1.0f) * kac), bvv = kk * a;
            const float bon = wave_sum(r * kpr * rkc);
            const size_t o = (size_t)m * RW + c;
            LW[o] = (_Float16)lwv; KP[o] = (bf16)f2bf(kpr); KK[o] = (bf16)f2bf(kk); BV[o] = (bf16)f2bf(bvv); RR[o] = (bf16)f2bf(r);
            if (F.lane == 0) BON[(size_t)m * NH + hh] = bon;
        }
        __syncthreads();
    }
}

__device__ __forceinline__ void phase_scan(const Frame& F, int l) {
    if (F.wave >= 4) return;
    const bf16* PROJ = (const bf16*)(F.ws + WS_PROJ);
    const _Float16* LW = (const _Float16*)(F.ws + WS_X1); const bf16* KP = (const bf16*)(F.ws + WS_X1 + 16 * MiB); const bf16* KK = (const bf16*)(F.ws + WS_X1 + 32 * MiB); const bf16* BV = (const bf16*)(F.ws + WS_X1 + 48 * MiB);
    const bf16* RR = (const bf16*)(F.ws + WS_HA + 16 * MiB); bf16* Y = (bf16*)(F.ws + WS_HA);
    for (int item = F.blk; item < NB * NH * 4; item += F.G) {
        const int bh = item >> 2, rb = item & 3, b = bh >> 3, h = bh & 7;
        const int i = 16 * rb + 4 * F.wave + (F.lane >> 4), cg = F.lane & 15, ch = h * 64;
        const float muv = F.in[I_MURKV][l * 3 * RW + 2 * RW + ch + i];
        const size_t mb = (size_t)b * NT;
        const size_t cofs = ch + 4 * cg;
        float S0 = 0.f, S1 = 0.f, S2 = 0.f, S3 = 0.f, vprev = 0.f;
        for (int t0 = 0; t0 < NT; t0 += 8) {
            typedef _Float16 h4 __attribute__((ext_vector_type(4)));
            v2u kkr[8], bvr[8], kpr[8], rrr[8]; h4 lwr[8]; unsigned short vr[8];
#pragma unroll
            for (int s = 0; s < 8; ++s) { const size_t m = mb + t0 + s, o = m * RW + cofs;
                kkr[s] = *(const GAS v2u*)(KK + o); bvr[s] = *(const GAS v2u*)(BV + o); kpr[s] = *(const GAS v2u*)(KP + o); rrr[s] = *(const GAS v2u*)(RR + o);
                lwr[s] = *(const GAS h4*)(LW + o); vr[s] = PROJ[m * NP + C_V + ch + i]; }
#pragma unroll
            for (int s = 0; s < 8; ++s) {
                const float k0 = bflo(kkr[s].x), k1 = bfhi(kkr[s].x), k2 = bflo(kkr[s].y), k3 = bfhi(kkr[s].y);
                const float b0 = bflo(bvr[s].x), b1 = bfhi(bvr[s].x), b2 = bflo(bvr[s].y), b3 = bfhi(bvr[s].y);
                const float p0 = bflo(kpr[s].x), p1 = bfhi(kpr[s].x), p2 = bflo(kpr[s].y), p3 = bfhi(kpr[s].y);
                const float r0 = bflo(rrr[s].x), r1 = bfhi(rrr[s].x), r2 = bflo(rrr[s].y), r3 = bfhi(rrr[s].y);
                const float w0 = __expf((float)lwr[s].x), w1 = __expf((float)lwr[s].y), w2 = __expf((float)lwr[s].z), w3 = __expf((float)lwr[s].w);
                const float vc = bf2f(vr[s]); const float v = vc + (vprev - vc) * muv; vprev = vc;
                const float sa = -allreduce16((S0 * k0 + S1 * k1) + (S2 * k2 + S3 * k3));
                S0 = S0 * w0 + (sa * b0 + v * p0); S1 = S1 * w1 + (sa * b1 + v * p1); S2 = S2 * w2 + (sa * b2 + v * p2); S3 = S3 * w3 + (sa * b3 + v * p3);
                const float y = allreduce16((S0 * r0 + S1 * r1) + (S2 * r2 + S3 * r3));
                if (cg == 0) Y[(mb + t0 + s) * RW + ch + i] = (bf16)f2bf(y);
            }
        }
    }
}


__device__ __forceinline__ void phase_scan_simple(const Frame& F, int l) {
    if (F.wave >= 1 || F.blk >= NB * NH) return;
    LAS float* sh = (LAS float*)F.lds;
    const bf16* PROJ = (const bf16*)(F.ws + WS_PROJ);
    const _Float16* LW = (const _Float16*)(F.ws + WS_X1); const bf16* KP = (const bf16*)(F.ws + WS_X1 + 16 * MiB); const bf16* KK = (const bf16*)(F.ws + WS_X1 + 32 * MiB); const bf16* BV = (const bf16*)(F.ws + WS_X1 + 48 * MiB);
    const bf16* RR = (const bf16*)(F.ws + WS_HA + 16 * MiB); bf16* Y = (bf16*)(F.ws + WS_HA);
    const int b = F.blk >> 3, h = F.blk & 7, lane = F.lane, c = h * 64 + lane;
    const float muv = F.in[I_MURKV][l * 3 * RW + 2 * RW + c];
    float S[64];
#pragma unroll
    for (int j = 0; j < 64; ++j) S[j] = 0.f;
    float vprev = 0.f;
    for (int t = 0; t < NT; ++t) {
        const size_t m = (size_t)b * NT + t, o = m * RW + c;
        sh[lane] = __expf((float)LW[o]); sh[64 + lane] = bf2f(KK[o]); sh[128 + lane] = bf2f(BV[o]); sh[192 + lane] = bf2f(KP[o]); sh[256 + lane] = bf2f(RR[o]);
        const float vc = bf2f(PROJ[m * NP + C_V + c]); const float v = vc + (vprev - vc) * muv; vprev = vc;
        LDS_WAIT(); asm volatile("" ::: "memory");
        float sa = 0.f;
#pragma unroll
        for (int j = 0; j < 64; ++j) sa -= S[j] * sh[64 + j];
        float y = 0.f;
#pragma unroll
        for (int j = 0; j < 64; ++j) { S[j] = S[j] * sh[j] + sa * sh[128 + j] + v * sh[192 + j]; y += S[j] * sh[256 + j]; }
        Y[o] = (bf16)f2bf(y);
        LDS_WAIT(); asm volatile("" ::: "memory");
    }
}
__device__ __forceinline__ void phase_post(const Frame& F, int l) {
    LAS float* lin = (LAS float*)F.lds;
    const int c = F.tid, hh = F.wave;
    const bf16* PROJ = (const bf16*)(F.ws + WS_PROJ); const bf16* Y = (const bf16*)(F.ws + WS_HA); const float* BON = (const float*)(F.ws + WS_BON);
    bf16* MIX = (bf16*)(F.ws + WS_HB);
    const float lg_ = F.in[I_LNXG][l * RW + c], lb_ = F.in[I_LNXB][l * RW + c], muv = F.in[I_MURKV][l * 3 * RW + 2 * RW + c];
    float G2r[128];
#pragma unroll
    for (int j = 0; j < 128; ++j) G2r[j] = F.in[I_G2][((size_t)l * 128 + j) * RW + c];
    for (int tile = F.blk; tile < M / 64; tile += F.G) {
        const int m0 = tile * 64;
        float vprev = 0.f;
        if ((m0 % NT) != 0) vprev = bf2f(PROJ[(size_t)(m0 - 1) * NP + C_V + c]);
        for (int i = 0; i < 64; ++i) {
            const int m = m0 + i, t = m % NT, buf = (i & 1) * 128;
            if (c < 128) { const float p = bf2f(PROJ[(size_t)m * NP + C_PG + c]); const float q = t > 0 ? bf2f(PROJ[(size_t)(m - 1) * NP + C_QG + c]) : 0.f; lin[buf + c] = sigmoidf_(p + q); }
            const float vc = bf2f(PROJ[(size_t)m * NP + C_V + c]); const float y = bf2f(Y[(size_t)m * RW + c]); const float bon = BON[(size_t)m * NH + hh];
            __syncthreads();
            float g = 0.f;
#pragma unroll
            for (int j = 0; j < 128; j += 4) { const f32x4 l4 = *(const LAS f32x4*)(lin + buf + j); g += l4.x * G2r[j] + l4.y * G2r[j + 1] + l4.z * G2r[j + 2] + l4.w * G2r[j + 3]; }
            const float v = vc + (vprev - vc) * muv; vprev = vc;
            const float mean = wave_sum(y) * (1.f / 64.f), d = y - mean, var = wave_sum(d * d) * (1.f / 64.f);
            const float yn = d * rsqrtf(var + GN_EPS) * lg_ + lb_ + bon * v;
            MIX[(size_t)m * DM + c] = (bf16)f2bf(yn * g);
        }
        __syncthreads();
    }
}
__device__ __forceinline__ void phase_sc(const Frame& F, int l) {
    const bf16* PROJ = (const bf16*)(F.ws + WS_PROJ); bf16* MIX = (bf16*)(F.ws + WS_HB);
    const int c = F.tid & 255, sub = F.tid >> 8;
    const float w0 = F.in[I_SCW][(l * 3 + 0) * 256 + c], w1 = F.in[I_SCW][(l * 3 + 1) * 256 + c], w2 = F.in[I_SCW][(l * 3 + 2) * 256 + c];
    for (int m = F.blk * 2 + sub; m < M; m += F.G * 2) {
        const int t = m % NT; const bf16* p = PROJ + (size_t)m * NP;
        float acc = w2 * bf2f(p[C_SCC + c]) * bf2f(p[C_SCU + c]);
        if (t >= 1) acc += w1 * bf2f(p[C_SCC + c - NP]) * bf2f(p[C_SCU + c - NP]);
        if (t >= 2) acc += w0 * bf2f(p[C_SCC + c - 2 * NP]) * bf2f(p[C_SCU + c - 2 * NP]);
        MIX[(size_t)m * DM + 512 + c] = (bf16)f2bf(bf2f(p[C_SCB + c]) * acc);
    }
}
__device__ __forceinline__ void phase_cf(const Frame& F, int l) {
    const bf16* PROJ = (const bf16*)(F.ws + WS_PROJ); bf16* MIX = (bf16*)(F.ws + WS_HB);
    LAS float* U = (LAS float*)F.lds;
    LAS float* CT = (LAS float*)(F.lds + 62 * 256 * 4);
    const int c = F.tid & 255, half = F.tid >> 8;
    float wr[31];
#pragma unroll
    for (int k = 0; k < 31; ++k) wr[k] = F.in[I_CFW][((size_t)l * 31 + k) * 256 + c];
    const float cb = F.in[I_CFB][l * 256 + c];
    const f32x4 lng = *(const f32x4*)(F.in[I_CFLG] + l * 256 + 4 * F.lane), lnb = *(const f32x4*)(F.in[I_CFLB] + l * 256 + 4 * F.lane);
    for (int tile = F.blk; tile < M / 32; tile += F.G) {
        const int m0 = tile * 32, t0 = m0 % NT;
        for (int idx = F.tid; idx < 62 * 256; idx += NTHR) { const int rr = idx >> 8, cc = idx & 255; const int tt = t0 - 30 + rr;
            float u = 0.f;
            if (tt >= 0) { const bf16* p = PROJ + (size_t)(m0 - 30 + rr) * NP; u = bf2f(p[C_CFV + cc]) * sigmoidf_(bf2f(p[C_CFG + cc])); }
            U[idx] = u; }
        __syncthreads();
#pragma unroll 1
        for (int ii = 0; ii < 16; ++ii) { const int i = half * 16 + ii; float acc = cb;
#pragma unroll
            for (int k = 0; k < 31; ++k) acc += wr[k] * U[(i + k) * 256 + c];
            CT[i * 256 + c] = acc; }
        __syncthreads();
#pragma unroll 1
        for (int q = 0; q < 4; ++q) { const int i = F.wave * 4 + q;
            const f32x4 x = *(const LAS f32x4*)(CT + i * 256 + 4 * F.lane);
            const float mean = wave_sum((x.x + x.y) + (x.z + x.w)) * (1.f / 256.f);
            const f32x4 d = x - mean;
            const float var = wave_sum((d.x * d.x + d.y * d.y) + (d.z * d.z + d.w * d.w)) * (1.f / 256.f);
            const float rs = rsqrtf(var + LN_EPS);
            f32x4 y = d * rs * lng + lnb;
            y.x = y.x * sigmoidf_(y.x); y.y = y.y * sigmoidf_(y.y); y.z = y.z * sigmoidf_(y.z); y.w = y.w * sigmoidf_(y.w);
            *(GAS unsigned long long*)(MIX + (size_t)(m0 + i) * DM + 768 + 4 * F.lane) = (unsigned long long)pk2(y.x, y.y) | ((unsigned long long)pk2(y.z, y.w) << 32); }
        __syncthreads();
    }
}

#if DIAG
#ifndef DIAG_L
#define DIAG_L 0
#endif
__device__ __forceinline__ void diag_acc(unsigned char* ws, int id, float num, float den) {
    float* D = (float*)(ws + WS_CTL + 32768);
    num = wave_sum(num); den = wave_sum(den);
    if ((threadIdx.x & 63) == 0) { atomicAdd(D + 2 * id, num); atomicAdd(D + 2 * id + 1, den); }
}
__device__ __forceinline__ float dg_lora_w(const Args& a, int l, int k, int c) {
    int q = c - C_PW; const int isq = q >= 256; q -= isq * 256;
    const int which = q < 64 ? 0 : q < 128 ? 1 : 2, j = which == 0 ? q : which == 1 ? q - 64 : q - 128, Nn = which == 2 ? 128 : 64;
    const float* W = (which == 0 ? a.in[I_W1] : which == 1 ? a.in[I_A1] : a.in[I_G1]) + (size_t)l * DM * Nn;
    const float mu = a.in[I_MUWAG][(size_t)l * 3 * DM + which * DM + k];
    return W[(size_t)k * Nn + j] * (isq ? mu : 1.0f - mu);
}
__global__ void __launch_bounds__(512) diag_proj(Args a, int l) {
    __shared__ float hrow[DM];
    const int m = blockIdx.x * 257, tid = threadIdx.x;
    const bf16* HA = (const bf16*)(a.ws + WS_HA); const bf16* PROJ = (const bf16*)(a.ws + WS_PROJ);
    for (int k = tid; k < DM; k += 512) hrow[k] = bf2f(HA[(size_t)m * DM + k]);
    __syncthreads();
    float n0 = 0.f, d0 = 0.f, n1 = 0.f, d1 = 0.f;
    for (int c = tid; c < NP; c += 512) {
        float ref = 0.f;
        if (c < INW) { const float* W = a.in[I_WIN] + (size_t)l * DM * INW + c; for (int k = 0; k < DM; ++k) ref += hrow[k] * W[(size_t)k * INW]; }
        else for (int k = 0; k < DM; ++k) ref += hrow[k] * dg_lora_w(a, l, k, c);
        const float got = bf2f(PROJ[(size_t)m * NP + c]), e = ref - got;
        if (c < INW) { n0 += e * e; d0 += ref * ref; } else { n1 += e * e; d1 += ref * ref; }
    }
    diag_acc(a.ws, 0, n0, d0); diag_acc(a.ws, 1, n1, d1);
}
__global__ void __launch_bounds__(64) diag_y(Args a, int l) {
    __shared__ float sh[5][64]; __shared__ float sh2[5][64]; __shared__ float lin[128];
    const int b = blockIdx.x, h = blockIdx.x, lane = threadIdx.x, c = h * 64 + lane;
    const bf16* PROJ = (const bf16*)(a.ws + WS_PROJ); const bf16* Y = (const bf16*)(a.ws + WS_HA);
    const float w0c = a.in[I_W0][l * RW + c], a0c = a.in[I_A0][l * RW + c], kkc = a.in[I_KK][l * RW + c], kac = a.in[I_KA][l * RW + c];
    const float mur = a.in[I_MURKV][l * 3 * RW + c], muk = a.in[I_MURKV][l * 3 * RW + RW + c], muv = a.in[I_MURKV][l * 3 * RW + 2 * RW + c];
    float S[64];
#pragma unroll
    for (int j = 0; j < 64; ++j) S[j] = 0.f;
    float rprev = 0.f, kprev = 0.f, vprev = 0.f, num = 0.f, den = 0.f, num2 = 0.f, den2 = 0.f, pn[5] = {0.f, 0.f, 0.f, 0.f, 0.f}, pd[5] = {0.f, 0.f, 0.f, 0.f, 0.f};
    float S2[64];
#pragma unroll
    for (int j = 0; j < 64; ++j) S2[j] = 0.f;
    for (int t = 0; t < NT; ++t) {
        const size_t m = (size_t)b * NT + t; const bf16* p = PROJ + m * NP;
        float pw = bf2f(p[C_PW + lane]), pa = bf2f(p[C_PA + lane]);
        if (t > 0) { pw += bf2f(p[C_QW + lane - NP]); pa += bf2f(p[C_QA + lane - NP]); }
        lin[lane] = tanhf(pw); lin[64 + lane] = pa;
        __syncthreads();
        float wp = w0c, ap = a0c;
        for (int j = 0; j < 64; ++j) { wp += lin[j] * a.in[I_W2][((size_t)l * 64 + j) * RW + c]; ap += lin[64 + j] * a.in[I_A2][((size_t)l * 64 + j) * RW + c]; }
        const float av = 1.f / (1.f + expf(-ap)), w = expf(-0.60653065971f / (1.f + expf(-wp)));
        const float rp = bf2f(p[C_R + c]), kp_ = bf2f(p[C_K + c]), vp = bf2f(p[C_V + c]);
        const float r = rp + (rprev - rp) * mur, k = kp_ + (kprev - kp_) * muk, v = vp + (vprev - vp) * muv;
        rprev = rp; kprev = kp_; vprev = vp;
        const float kku = k * kkc; const float kk = kku / fmaxf(sqrtf(wave_sum(kku * kku)), 1e-12f);
        sh[0][lane] = w; sh[1][lane] = kk; sh[2][lane] = kk * av; sh[3][lane] = k * (1.f + (av - 1.f) * kac); sh[4][lane] = r;
        { const size_t o = m * RW + c;
          const float gw = expf((float)((const _Float16*)(a.ws + WS_X1))[o]), gkp = bf2f(((const bf16*)(a.ws + WS_X1 + 16 * MiB))[o]), gkk = bf2f(((const bf16*)(a.ws + WS_X1 + 32 * MiB))[o]);
          const float gbv = bf2f(((const bf16*)(a.ws + WS_X1 + 48 * MiB))[o]), grr = bf2f(((const bf16*)(a.ws + WS_HA + 16 * MiB))[o]);
          pn[0] += (gw - w) * (gw - w); pd[0] += w * w; pn[1] += (gkk - kk) * (gkk - kk); pd[1] += kk * kk; pn[2] += (gbv - kk * av) * (gbv - kk * av); pd[2] += kk * av * kk * av;
          pn[3] += (gkp - sh[3][lane]) * (gkp - sh[3][lane]); pd[3] += sh[3][lane] * sh[3][lane]; pn[4] += (grr - r) * (grr - r); pd[4] += r * r;
          sh2[0][lane] = gw; sh2[1][lane] = gkk; sh2[2][lane] = gbv; sh2[3][lane] = gkp; sh2[4][lane] = grr; }
        __syncthreads();
        float sa = 0.f;
#pragma unroll
        for (int j = 0; j < 64; ++j) sa -= S[j] * sh[1][j];
        float y = 0.f;
#pragma unroll
        for (int j = 0; j < 64; ++j) { S[j] = S[j] * sh[0][j] + sa * sh[2][j] + v * sh[3][j]; y += S[j] * sh[4][j]; }
        const float got = bf2f(Y[m * RW + c]), e = y - got;
        num += e * e; den += y * y;
        { float sa2 = 0.f;
#pragma unroll
          for (int j = 0; j < 64; ++j) sa2 -= S2[j] * sh2[1][j];
          float y2 = 0.f;
#pragma unroll
          for (int j = 0; j < 64; ++j) { S2[j] = S2[j] * sh2[0][j] + sa2 * sh2[2][j] + v * sh2[3][j]; y2 += S2[j] * sh2[4][j]; }
          num2 += (y2 - got) * (y2 - got); den2 += y2 * y2; }
        __syncthreads();
    }
    diag_acc(a.ws, 2, num, den);
#pragma unroll
    for (int q = 0; q < 5; ++q) diag_acc(a.ws, 12 + q, pn[q], pd[q]);
    diag_acc(a.ws, 17, num2, den2);
}
__global__ void __launch_bounds__(512) diag_mix(Args a, int l) {
    __shared__ float lg[128], la[64], red[16];
    const int m = blockIdx.x * 257 + 40, t = m % NT, c = threadIdx.x, lane = c & 63, wv = c >> 6;
    const bf16* PROJ = (const bf16*)(a.ws + WS_PROJ); const bf16* Y = (const bf16*)(a.ws + WS_HA); const bf16* MIX = (const bf16*)(a.ws + WS_HB);
    const bf16* p = PROJ + (size_t)m * NP;
    if (c < 128) lg[c] = 1.f / (1.f + expf(-(bf2f(p[C_PG + c]) + (t > 0 ? bf2f(p[C_QG + c - NP]) : 0.f))));
    else if (c < 192) la[c - 128] = bf2f(p[C_PA + c - 128]) + (t > 0 ? bf2f(p[C_QA + c - 128 - NP]) : 0.f);
    __syncthreads();
    float g = 0.f, ap = a.in[I_A0][l * RW + c];
    for (int j = 0; j < 128; ++j) g += lg[j] * a.in[I_G2][((size_t)l * 128 + j) * RW + c];
    for (int j = 0; j < 64; ++j) ap += la[j] * a.in[I_A2][((size_t)l * 64 + j) * RW + c];
    const float av = 1.f / (1.f + expf(-ap));
    const float mur = a.in[I_MURKV][l * 3 * RW + c], muk = a.in[I_MURKV][l * 3 * RW + RW + c], muv = a.in[I_MURKV][l * 3 * RW + 2 * RW + c];
    float r = bf2f(p[C_R + c]), k = bf2f(p[C_K + c]), v = bf2f(p[C_V + c]);
    if (t > 0) { r += (bf2f(p[C_R + c - NP]) - r) * mur; k += (bf2f(p[C_K + c - NP]) - k) * muk; v += (bf2f(p[C_V + c - NP]) - v) * muv; }
    else { r -= r * mur; k -= k * muk; v -= v * muv; }
    const float kp = k * (1.f + (av - 1.f) * a.in[I_KA][l * RW + c]);
    const float bon = wave_sum(r * kp * a.in[I_RK][l * RW + c]);
    const float y = bf2f(Y[(size_t)m * RW + c]);
    const float mean = wave_sum(y) * (1.f / 64.f), dd = y - mean, var = wave_sum(dd * dd) * (1.f / 64.f);
    const float ref = (dd * rsqrtf(var + GN_EPS) * a.in[I_LNXG][l * RW + c] + a.in[I_LNXB][l * RW + c] + bon * v) * g;
    const float got = bf2f(MIX[(size_t)m * DM + c]);
    diag_acc(a.ws, 3, (ref - got) * (ref - got), ref * ref);
    float n4 = 0.f, d4 = 0.f, n5 = 0.f, d5 = 0.f, cv = 0.f;
    if (c < 256) {
        float acc = 0.f;
        for (int kk = 0; kk < 3; ++kk) { const int tt = t - 2 + kk; if (tt >= 0) { const bf16* q = p - (size_t)(2 - kk) * NP; acc += a.in[I_SCW][(l * 3 + kk) * 256 + c] * bf2f(q[C_SCC + c]) * bf2f(q[C_SCU + c]); } }
        const float rs = bf2f(p[C_SCB + c]) * acc, gs = bf2f(MIX[(size_t)m * DM + 512 + c]);
        n4 = (rs - gs) * (rs - gs); d4 = rs * rs;
        cv = a.in[I_CFB][l * 256 + c];
        for (int kk = 0; kk < 31; ++kk) { const int tt = t - 30 + kk; if (tt >= 0) { const bf16* q = p - (size_t)(30 - kk) * NP; cv += a.in[I_CFW][((size_t)l * 31 + kk) * 256 + c] * bf2f(q[C_CFV + c]) / (1.f + expf(-bf2f(q[C_CFG + c]))); } }
    }
    diag_acc(a.ws, 4, n4, d4);
    float s = wave_sum(c < 256 ? cv : 0.f);
    if (lane == 0) red[wv] = s;
    __syncthreads();
    const float mean5 = (red[0] + red[1] + red[2] + red[3]) * (1.f / 256.f);
    const float dv = cv - mean5; s = wave_sum(c < 256 ? dv * dv : 0.f);
    if (lane == 0) red[8 + wv] = s;
    __syncthreads();
    const float var5 = (red[8] + red[9] + red[10] + red[11]) * (1.f / 256.f);
    if (c < 256) { float yy = dv * rsqrtf(var5 + LN_EPS) * a.in[I_CFLG][l * 256 + c] + a.in[I_CFLB][l * 256 + c]; yy = yy / (1.f + expf(-yy));
        const float gc = bf2f(MIX[(size_t)m * DM + 768 + c]); n5 = (yy - gc) * (yy - gc); d5 = yy * yy; }
    diag_acc(a.ws, 5, n5, d5);
}
__global__ void __launch_bounds__(512) diag_gemm_f32(Args a, size_t a_off, int K, int w_idx, size_t w_eloff, size_t tmp_off, int id) {
    __shared__ float arow[FF];
    const bf16* A = (const bf16*)(a.ws + a_off); const float* W = a.in[w_idx] + w_eloff; const float* TMP = (const float*)(a.ws + tmp_off);
    const int m = blockIdx.x * 257 + 7, tid = threadIdx.x;
    for (int k = tid; k < K; k += 512) arow[k] = bf2f(A[(size_t)m * K + k]);
    __syncthreads();
    float n = 0.f, d = 0.f;
    for (int c = tid; c < DM; c += 512) { float ref = 0.f; for (int k = 0; k < K; ++k) ref += arow[k] * W[(size_t)k * DM + c];
        const float e = ref - TMP[(size_t)m * DM + c]; n += e * e; d += ref * ref; }
    diag_acc(a.ws, id, n, d);
}
__global__ void __launch_bounds__(512) diag_norm(Args a, size_t tmp_off, int l, int id) {
    __shared__ float red[16];
    const float* TMP = (const float*)(a.ws + tmp_off); const float* xold = a.in[I_X]; const float* g1 = a.in[I_POSTMIX] + l * DM; const float* g2 = a.in[I_PREFFN] + l * DM;
    const int m = blockIdx.x * 257 + 7, tid = threadIdx.x, lane = tid & 63, wv = tid >> 6;
    const bf16* HA = (const bf16*)(a.ws + WS_HA);
    const float t0 = TMP[(size_t)m * DM + tid], t1 = TMP[(size_t)m * DM + 512 + tid];
    float s = wave_sum(t0 * t0 + t1 * t1); if (lane == 0) red[wv] = s; __syncthreads();
    float tot = 0.f; for (int i = 0; i < 8; ++i) tot += red[i];
    const float r = rsqrtf(tot * (1.f / DM) + NORM_EPS);
    const float x0 = xold[(size_t)m * DM + tid] + t0 * r * g1[tid], x1 = xold[(size_t)m * DM + 512 + tid] + t1 * r * g1[512 + tid];
    const float e0 = x0 - a.out[(size_t)m * DM + tid], e1 = x1 - a.out[(size_t)m * DM + 512 + tid];
    diag_acc(a.ws, id, e0 * e0 + e1 * e1, x0 * x0 + x1 * x1);
    s = wave_sum(x0 * x0 + x1 * x1); if (lane == 0) red[8 + wv] = s; __syncthreads();
    tot = 0.f; for (int i = 0; i < 8; ++i) tot += red[8 + i];
    const float r2 = rsqrtf(tot * (1.f / DM) + NORM_EPS);
    const float h0 = x0 * r2 * g2[tid], h1 = x1 * r2 * g2[512 + tid];
    const float f0 = h0 - bf2f(HA[(size_t)m * DM + tid]), f1 = h1 - bf2f(HA[(size_t)m * DM + 512 + tid]);
    diag_acc(a.ws, id + 1, f0 * f0 + f1 * f1, h0 * h0 + h1 * h1);
}
__global__ void __launch_bounds__(512) diag_swiglu(Args a, int l) {
    __shared__ float hrow[DM];
    const int m = blockIdx.x * 257 + 11, tid = threadIdx.x;
    const bf16* HA = (const bf16*)(a.ws + WS_HA); const bf16* Fb = (const bf16*)(a.ws + WS_PROJ);
    for (int k = tid; k < DM; k += 512) hrow[k] = bf2f(HA[(size_t)m * DM + k]);
    __syncthreads();
    float n = 0.f, d = 0.f;
    for (int c = tid; c < FF; c += 512) { float gg = 0.f, uu = 0.f; const float* Wg = a.in[I_WGATE] + (size_t)l * DM * FF + c; const float* Wu = a.in[I_WUP] + (size_t)l * DM * FF + c;
        for (int k = 0; k < DM; ++k) { gg += hrow[k] * Wg[(size_t)k * FF]; uu += hrow[k] * Wu[(size_t)k * FF]; }
        const float ref = gg / (1.f + expf(-gg)) * uu, e = ref - bf2f(Fb[(size_t)m * FF + c]); n += e * e; d += ref * ref; }
    diag_acc(a.ws, 11, n, d);
}
constexpr int DIAG_NID = 18;
__global__ void __launch_bounds__(256) diag_encode(Args a) {
    const float* D = (const float*)(a.ws + WS_CTL + 32768);
    int idx = 15; float dsel = 0.f;
    for (int q = 0; q < DIAG_NID; ++q) { const float d = D[2 * q] / fmaxf(D[2 * q + 1], 1e-30f); if (d > dsel) dsel = d; }
    for (int qq = 0; qq < DIAG_NID; ++qq) { const int q = qq < 6 ? 12 + qq : qq - 6; const float d = D[2 * q] / fmaxf(D[2 * q + 1], 1e-30f); if (!(d < 1e-3f)) { idx = qq; dsel = d; break; } }
    const float c = 3000.f * sqrtf(dsel);
    for (size_t i = (size_t)blockIdx.x * 256 + threadIdx.x; i < (size_t)M * DM; i += (size_t)gridDim.x * 256) a.out[i] = c;
    if (blockIdx.x == 0 && threadIdx.x == 0) a.out[0] = c * powf(1.6f, (float)(idx + 6));
}
#endif
#ifndef PH_MASK
#define PH_MASK 0x3ff
#endif
#define PH_ON(k) (((PH_MASK) >> (k)) & 1)
constexpr int PH_PER_LAYER = 10, N_PHASES = NL * PH_PER_LAYER;
__global__ void __launch_bounds__(NTHR, 2) fwd(Args args) {
    extern __shared__ __attribute__((aligned(16))) unsigned char lds_raw[];
    Frame F;
    F.lds = (LAS unsigned char*)lds_raw;
    F.tid = threadIdx.x; F.lane = F.tid & 63; F.wave = __builtin_amdgcn_readfirstlane(F.tid >> 6);
    F.blk = blockIdx.x; F.G = gridDim.x; F.in = args.in; F.out = args.out; F.ws = args.ws;
    volatile LAS unsigned* MISC = (volatile LAS unsigned*)(F.lds + MISC_OFF);
    if (F.tid < 32) MISC[F.tid] = 0u;
    __syncthreads();
    XcdBarrier bar; bar.bar = (unsigned*)(F.ws + WS_CTL) + 4096; bar.x = 0; bar.st = nullptr;
    const bool multi = (args.ph_hi - args.ph_lo) > 1;
    if (multi) bar = xcd_barrier_post((unsigned*)(F.ws + WS_CTL) + 4096, MISC + 8);
    bf16* WIN = (bf16*)(F.ws + WS_WIN); bf16* WO = (bf16*)(F.ws + WS_WO); bf16* WGU = (bf16*)(F.ws + WS_WGU); bf16* WDN = (bf16*)(F.ws + WS_WDN);
    bf16* HA = (bf16*)(F.ws + WS_HA); bf16* HB = (bf16*)(F.ws + WS_HB); bf16* PROJ = (bf16*)(F.ws + WS_PROJ);
    float* TMP1 = (float*)(F.ws + WS_PROJ); float* TMP2 = (float*)(F.ws + WS_X1);
    for (int ph = args.ph_lo; ph < args.ph_hi; ++ph) {
        const int l = ph / PH_PER_LAYER, k = ph % PH_PER_LAYER;
        { int t_ = threadIdx.x; asm volatile("" : "+v"(t_)); F.tid = t_; F.lane = t_ & 63; F.wave = __builtin_amdgcn_readfirstlane(t_ >> 6); }
        switch (k) {
        case 0: if (PH_ON(0)) { phase_conv(F, l); if (l == 0) phase_norm0(F); } break;
        case 1: if (PH_ON(1)) { pg8::Gemm g{HA, WIN, M, NP, DM}; pg8::StaticOrder S; S.init(M, NP, F.G, F.blk); pg8::EpiBf16 E{PROJ, NP};
                  pg8::gemm_phase<pg8::EpiBf16, pg8::StaticOrder, true, true>(F.lds, g, S, E); } break;
        case 2: if (PH_ON(2)) phase_prep(F, l); break;
        case 3: if (PH_ON(3)) phase_scan(F, l); break;
        case 4: if (PH_ON(4)) { phase_post(F, l); phase_sc(F, l); phase_cf(F, l); } break;
        case 5: if (PH_ON(5)) { pg8::Gemm g{HB, WO, M, DM, DM}; pg8::StaticOrder S; S.init(M, DM, F.G, F.blk); pg8::EpiF32 E{TMP1, DM};
                  pg8::gemm_phase<pg8::EpiF32, pg8::StaticOrder, true, true>(F.lds, g, S, E); } break;
        case 6: if (PH_ON(6)) phase_norm_res(F, TMP1, l == 0 ? F.in[I_X] : F.out, F.in[I_POSTMIX] + l * DM, F.in[I_PREFFN] + l * DM); break;
        case 7: if (PH_ON(7)) { pg8::Gemm g{HA, WGU, M, NGU, DM}; pg8::StaticOrder S; S.init(M, NGU, F.G, F.blk); pg8::EpiSwiGLU E{PROJ, FF};
                  pg8::gemm_phase<pg8::EpiSwiGLU, pg8::StaticOrder, true, true>(F.lds, g, S, E); } break;
        case 8: if (PH_ON(8)) { pg8::Gemm g{PROJ, WDN, M, DM, FF}; pg8::StaticOrder S; S.init(M, DM, F.G, F.blk); pg8::EpiF32 E{TMP2, DM};
                  pg8::gemm_phase<pg8::EpiF32, pg8::StaticOrder, true, true>(F.lds, g, S, E); } break;
        case 9: if (PH_ON(9)) phase_norm_res(F, TMP2, F.out, F.in[I_POSTFFN] + l * DM, l + 1 < NL ? F.in[I_PREMIX] + (l + 1) * DM : nullptr); break;
        }
        if (ph + 1 < args.ph_hi) xcd_barrier(bar);
    }
}

#ifndef MK_ONE_LAUNCH
#define MK_ONE_LAUNCH 0
#endif
extern "C" void kernel_launch(void* const* d_in, const int* in_sizes, int n_in, void* d_out, int out_size, void* d_ws, size_t ws_size, hipStream_t stream) {
    static int grid = 0;
    if (grid == 0) {
        if (n_in != N_IN || in_sizes[0] != M * DM || out_size != M * DM || ws_size < WS_END) { fprintf(stderr, "kernel_launch: unexpected shapes (n_in %d, ws %zu)\n", n_in, ws_size); grid = -1; return; }
        int dev = 0, cus = 0, per_cu = 0;
        if (hipGetDevice(&dev) != hipSuccess || hipDeviceGetAttribute(&cus, hipDeviceAttributeMultiprocessorCount, dev) != hipSuccess) { grid = -1; return; }
        if (hipFuncSetAttribute((const void*)fwd, hipFuncAttributeMaxDynamicSharedMemorySize, LDS_BYTES) != hipSuccess) { fprintf(stderr, "kernel_launch: hipFuncSetAttribute failed\n"); grid = -1; return; }
        if (hipOccupancyMaxActiveBlocksPerMultiprocessor(&per_cu, (const void*)fwd, NTHR, LDS_BYTES) != hipSuccess || per_cu < 1) { fprintf(stderr, "kernel_launch: occupancy query says %d blocks per CU\n", per_cu); grid = -1; (void)hipGetLastError(); return; }
        grid = cus;
    }
    if (grid < 0) return;
    (void)hipMemsetAsync((char*)d_ws + WS_CTL, 0, CTL_ZERO_BYTES, stream);
    Args a{};
    for (int i = 0; i < N_IN; ++i) a.in[i] = (const float*)d_in[i];
    a.out = (float*)d_out; a.ws = (unsigned char*)d_ws;
#if MK_ONE_LAUNCH
    a.ph_lo = 0; a.ph_hi = N_PHASES;
    hipLaunchKernelGGL(fwd, dim3(grid), dim3(NTHR), LDS_BYTES, stream, a);
#else
    for (int ph = 0; ph < N_PHASES; ++ph) { a.ph_lo = ph; a.ph_hi = ph + 1; hipLaunchKernelGGL(fwd, dim3(grid), dim3(NTHR), LDS_BYTES, stream, a);
#if DIAG
        const int l = ph / PH_PER_LAYER, k = ph % PH_PER_LAYER;
        if (l == DIAG_L) {
            if (k == 1) hipLaunchKernelGGL(diag_proj, dim3(64), dim3(512), 0, stream, a, l);
            if (k == 3) hipLaunchKernelGGL(diag_y, dim3(8), dim3(64), 0, stream, a, l);
            if (k == 4) hipLaunchKernelGGL(diag_mix, dim3(63), dim3(512), 0, stream, a, l);
            if (k == 5) hipLaunchKernelGGL(diag_gemm_f32, dim3(63), dim3(512), 0, stream, a, (size_t)WS_HB, (int)DM, (int)I_WO, (size_t)l * DM * DM, (size_t)WS_PROJ, 6);
            if (k == 6 && l == 0) hipLaunchKernelGGL(diag_norm, dim3(63), dim3(512), 0, stream, a, (size_t)WS_PROJ, l, 7);
            if (k == 7) hipLaunchKernelGGL(diag_swiglu, dim3(63), dim3(512), 0, stream, a, l);
            if (k == 8) hipLaunchKernelGGL(diag_gemm_f32, dim3(63), dim3(512), 0, stream, a, (size_t)WS_PROJ, (int)FF, (int)I_WDOWN, (size_t)l * FF * DM, (size_t)WS_X1, 9);
        }
#endif
    }
#if DIAG
    hipLaunchKernelGGL(diag_encode, dim3(1024), dim3(256), 0, stream, a);
#endif
#endif
}
```

```cpp
#include <hip/hip_runtime.h>
#include <cstdio>
#include <cstdint>
#ifndef DIAG
#define DIAG 0
#endif
namespace pg8 {
#define PG8_LAS __attribute__((address_space(3)))
typedef unsigned short bf16_t;
typedef short bf16x8 __attribute__((ext_vector_type(8)));
typedef float f32x4 __attribute__((ext_vector_type(4)));
typedef unsigned u32x4 __attribute__((ext_vector_type(4)));
constexpr int BM = 256, BK = 64, HALF = 128, HTB = HALF * BK * 2  , STAGE_BYTES = 8 * HTB, NXCD = 8, WGM = 8;

__host__ __device__ __forceinline__ int lds_byte(int r, int c) { const int st = (r >> 4) * 2 + (c >> 5), rr = r & 15, cc = c & 31, ob = rr * 64 + cc * 2; return st * 1024 + (ob ^ (((ob >> 9) & 1) << 5)); }
__host__ __device__ __forceinline__ void stage_rc(int b, int& R, int& C) { const int st = b / 1024, sb = b % 1024, swz = sb ^ (((sb >> 9) & 1) << 5); R = (st >> 1) * 16 + swz / 64; C = (st & 1) * 32 + (swz % 64) / 2; }
__host__ __device__ __forceinline__ int perm32(int rho) { const int n = rho >> 4, i = rho & 15; return 8 * (i >> 2) + 4 * n + (i & 3); }

struct Unit { int pm, pn; };
struct Gemm { const bf16_t* A; const bf16_t* Bt; int M, N, K; };

struct StaticOrder {
    int nM, nN, nwg, G, c;
    __host__ __device__ void init(int M, int N, int G_, int c_) { nM = M / BM; nN = N / BM; nwg = nM * nN; G = G_; c = c_; }
    __host__ __device__ bool next(int i, Unit& u) const {
        const long L = (long)i * G + c; if (L >= nwg) return false;
        int wgid = (int)L; { const int q = nwg / NXCD, r = nwg % NXCD, xcd = wgid % NXCD, off = wgid / NXCD; wgid = (xcd < r ? xcd * (q + 1) : r * (q + 1) + (xcd - r) * q) + off; }
        const int nig = WGM * nN, gid = wgid / nig, fm = gid * WGM, gsz = (nM - fm) < WGM ? (nM - fm) : WGM;
        u.pm = fm + ((wgid % nig) % gsz); u.pn = (wgid % nig) / gsz; return true;
    }
    __device__ __forceinline__ void a_ready(const Unit&) const {}
    __device__ __forceinline__ void done(const Unit&) const {}
};

__device__ __forceinline__ unsigned cvt_pk_bf16(float lo, float hi) { unsigned r; asm volatile("v_cvt_pk_bf16_f32 %0, %1, %2" : "=v"(r) : "v"(lo), "v"(hi)); return r; }
typedef float f32x2 __attribute__((ext_vector_type(2)));
struct EpiBf16 {
    static constexpr bool PERM = true, AFTER_DRAIN = false;
    bf16_t* O; int ldc;
    __device__ __forceinline__ void operator()(const f32x4 (&acc)[2][2][4][2], const Unit& u, int wr, int wc, int fr, int fq) const {
        const int row0 = u.pm * BM + wr * 64 + fr, col0 = u.pn * BM + wc * 32 + 8 * fq;
#pragma unroll
        for (int ai = 0; ai < 2; ++ai)
#pragma unroll
            for (int m = 0; m < 4; ++m) { bf16_t* rowp = O + (size_t)(row0 + ai * HALF + m * 16) * ldc + col0;
#pragma unroll
                for (int bj = 0; bj < 2; ++bj) { const f32x4 v0 = acc[ai][bj][m][0], v1 = acc[ai][bj][m][1];
                    u32x4 w; w.x = cvt_pk_bf16(v0[0], v0[1]); w.y = cvt_pk_bf16(v0[2], v0[3]); w.z = cvt_pk_bf16(v1[0], v1[1]); w.w = cvt_pk_bf16(v1[2], v1[3]);
                    *(u32x4*)(rowp + bj * HALF) = w; } }
    }
};
struct EpiF32 {
    static constexpr bool PERM = false, AFTER_DRAIN = false;
    float* C; int ldc;
    __device__ __forceinline__ void operator()(const f32x4 (&acc)[2][2][4][2], const Unit& u, int wr, int wc, int fr, int fq) const {
        const int row0 = u.pm * BM + wr * 64 + fr, col0 = u.pn * BM + wc * 32 + 4 * fq;
#pragma unroll
        for (int ai = 0; ai < 2; ++ai)
#pragma unroll
            for (int m = 0; m < 4; ++m) { float* rowp = C + (size_t)(row0 + ai * HALF + m * 16) * ldc + col0;
#pragma unroll
                for (int bj = 0; bj < 2; ++bj)
#pragma unroll
                    for (int n = 0; n < 2; ++n) *(f32x4*)(rowp + bj * HALF + n * 16) = acc[ai][bj][m][n]; }
    }
};
struct EpiSwiGLU {
    static constexpr bool PERM = true, AFTER_DRAIN = false;
    bf16_t* O; int ldc;
    __device__ __forceinline__ void operator()(const f32x4 (&acc)[2][2][4][2], const Unit& u, int wr, int wc, int fr, int fq) const {
        const int row0 = u.pm * BM + wr * 64 + fr, col0 = u.pn * HALF + wc * 32 + 8 * fq;
#pragma unroll
        for (int ai = 0; ai < 2; ++ai)
#pragma unroll
            for (int m = 0; m < 4; ++m) { bf16_t* rowp = O + (size_t)(row0 + ai * HALF + m * 16) * ldc + col0;
                float o[8];
#pragma unroll
                for (int n = 0; n < 2; ++n)
#pragma unroll
                    for (int e = 0; e < 4; ++e) { const float g = acc[ai][0][m][n][e], up = acc[ai][1][m][n][e];
                        o[n * 4 + e] = g * __builtin_amdgcn_rcpf(1.0f + __builtin_amdgcn_exp2f(-1.44269504089f * g)) * up; }
                u32x4 w; w.x = cvt_pk_bf16(o[0], o[1]); w.y = cvt_pk_bf16(o[2], o[3]); w.z = cvt_pk_bf16(o[4], o[5]); w.w = cvt_pk_bf16(o[6], o[7]);
                *(u32x4*)rowp = w; }
    }
};

template <class Epi, class Sched, bool ALIGN_EPI = false, bool SP2 = false>
__device__ __forceinline__ void gemm_phase(PG8_LAS unsigned char* lds, const Gemm g, const Sched& S, const Epi& E) {
    int tid_l = threadIdx.x; asm volatile("" : "+v"(tid_l));
    const int tid = tid_l, wid = __builtin_amdgcn_readfirstlane(tid >> 6), lane = tid & 63, wr = wid >> 2, wc = wid & 3, fr = lane & 15, fq = lane >> 4;
    const int K = g.K, nt = K / BK;
    unsigned voffA[2], voffB[2];
#pragma unroll
    for (int i = 0; i < 2; ++i) { int R, C; stage_rc(tid * 16 + i * 8192, R, C); const int Rb = Epi::PERM ? ((R & ~31) + perm32(R & 31)) : R;
        voffA[i] = (unsigned)(R * K + C) * 2u; voffB[i] = (unsigned)(Rb * K + C) * 2u; }
    const size_t kstep = (size_t)(BK * 2);
    const size_t hstep = (size_t)HALF * K * 2;
    const size_t tstep = 2 * hstep;
    const unsigned ldsw = (unsigned)wid * 1024u;
    const int aoff = lds_byte(wr * 64 + fr, fq * 8), boff = lds_byte(wc * 32 + fr, fq * 8);
#define PG8_SA(b, h) (((b) * 2 + (h)) * HTB)
#define PG8_SB(b, h) ((4 + (b) * 2 + (h)) * HTB)
#define PG8_STAGE(bufoff, gbase, voff) do { _Pragma("unroll") for (int _i = 0; _i < 2; ++_i) \
        __builtin_amdgcn_global_load_lds((const unsigned*)((const char*)(gbase) + (voff)[_i]), (PG8_LAS unsigned*)(lds + (bufoff) + ldsw + _i * 8192), 16, 0, 0); } while (0)
#define PG8_LDA(dst, b, h) do { _Pragma("unroll") for (int m = 0; m < 4; ++m) _Pragma("unroll") for (int k = 0; k < 2; ++k) dst[m][k] = *(const PG8_LAS bf16x8*)(lds + PG8_SA(b, h) + aoff + m * 2048 + k * 1024); } while (0)
#define PG8_LDB(dst, b, h) do { _Pragma("unroll") for (int n = 0; n < 2; ++n) _Pragma("unroll") for (int k = 0; k < 2; ++k) dst[n][k] = *(const PG8_LAS bf16x8*)(lds + PG8_SB(b, h) + boff + n * 2048 + k * 1024); } while (0)
#define PG8_MMA(ai, bj, At, Bt) do { __builtin_amdgcn_s_setprio(1); _Pragma("unroll") for (int m = 0; m < 4; ++m) _Pragma("unroll") for (int n = 0; n < 2; ++n) _Pragma("unroll") for (int k = 0; k < 2; ++k) \
        acc[ai][bj][m][n] = __builtin_amdgcn_mfma_f32_16x16x32_bf16(Bt[n][k], At[m][k], acc[ai][bj][m][n], 0, 0, 0); __builtin_amdgcn_s_setprio(0); } while (0)
#define PG8_WAIT_V(n) asm volatile("s_waitcnt vmcnt(" #n ")" ::: "memory")
#define PG8_WAIT_L(n) asm volatile("s_waitcnt lgkmcnt(" #n ")" ::: "memory")
#define PG8_BAR __builtin_amdgcn_s_barrier()
#define PG8_SCHED __builtin_amdgcn_sched_barrier(0)
    Unit cur, nxt; int ui = 0;
    if (!S.next(0, cur)) return;
    f32x4 acc[2][2][4][2];
#pragma unroll
    for (int a = 0; a < 2; ++a)
#pragma unroll
        for (int b = 0; b < 2; ++b)
#pragma unroll
            for (int m = 0; m < 4; ++m)
#pragma unroll
                for (int n = 0; n < 2; ++n) acc[a][b][m][n] = (f32x4){0.f, 0.f, 0.f, 0.f};
    bf16x8 At[4][2], B0[2][2], B1[2][2];
    const char* cA = (const char*)g.A + (size_t)cur.pm * tstep; const char* cB = (const char*)g.Bt + (size_t)cur.pn * tstep;
    S.a_ready(cur);
    if constexpr (SP2) {
        PG8_STAGE(PG8_SB(0, 0), cB, voffB); PG8_STAGE(PG8_SB(0, 1), cB + hstep, voffB); PG8_STAGE(PG8_SA(0, 0), cA, voffA); PG8_STAGE(PG8_SA(0, 1), cA + hstep, voffA);
        if (wr == 1) PG8_BAR;
        PG8_WAIT_V(2); PG8_BAR;
        PG8_STAGE(PG8_SB(1, 0), cB + kstep, voffB); PG8_STAGE(PG8_SA(1, 0), cA + kstep, voffA); PG8_STAGE(PG8_SB(1, 1), cB + hstep + kstep, voffB);
        PG8_WAIT_V(6); PG8_BAR;
    } else {
        PG8_STAGE(PG8_SB(0, 0), cB, voffB); PG8_STAGE(PG8_SA(0, 0), cA, voffA); PG8_STAGE(PG8_SB(0, 1), cB + hstep, voffB); PG8_STAGE(PG8_SA(0, 1), cA + hstep, voffA);
        if (wr == 1) PG8_BAR;
        PG8_WAIT_V(4); PG8_BAR;
        PG8_STAGE(PG8_SB(1, 0), cB + kstep, voffB); PG8_STAGE(PG8_SA(1, 0), cA + kstep, voffA); PG8_STAGE(PG8_SB(1, 1), cB + hstep + kstep, voffB);
        PG8_WAIT_V(6); PG8_BAR;
    }
    for (;;) {
        const bool has_next = S.next(ui + 1, nxt);
        const char* nA = has_next ? (const char*)g.A + (size_t)nxt.pm * tstep : cA; const char* nB = has_next ? (const char*)g.Bt + (size_t)nxt.pn * tstep : cB;
        for (int t = 0; t < nt; t += 2) {
            const bool last = (t == nt - 2);
            const char* a1 = cA + (size_t)(t + 1) * kstep;
            const char* a2 = last ? nA : cA + (size_t)(t + 2) * kstep; const char* b2 = last ? nB : cB + (size_t)(t + 2) * kstep;
            const char* a3 = a2 + kstep; const char* b3 = b2 + kstep;
            if (last && has_next) S.a_ready(nxt);
            if constexpr (SP2) {
            PG8_LDB(B0, 0, 0); PG8_LDB(B1, 0, 1); PG8_SCHED; PG8_LDA(At, 0, 0); PG8_STAGE(PG8_SA(1, 1), a1 + hstep, voffA);
            PG8_WAIT_V(8); PG8_WAIT_L(0); PG8_BAR; PG8_MMA(0, 0, At, B0); PG8_MMA(0, 1, At, B1); PG8_BAR; PG8_SCHED;
            PG8_LDA(At, 0, 1); PG8_STAGE(PG8_SB(0, 0), b2, voffB); PG8_STAGE(PG8_SB(0, 1), b2 + hstep, voffB); PG8_STAGE(PG8_SA(0, 0), a2, voffA);
            PG8_WAIT_V(8); PG8_WAIT_L(0); PG8_BAR; PG8_MMA(1, 0, At, B0); PG8_MMA(1, 1, At, B1); PG8_BAR; PG8_SCHED;
            PG8_LDB(B0, 1, 0); PG8_LDB(B1, 1, 1); PG8_SCHED; PG8_LDA(At, 1, 0); PG8_STAGE(PG8_SA(0, 1), a2 + hstep, voffA);
            PG8_WAIT_V(8); PG8_WAIT_L(0); PG8_BAR; PG8_MMA(0, 0, At, B0); PG8_MMA(0, 1, At, B1); PG8_BAR; PG8_SCHED;
            PG8_LDA(At, 1, 1); PG8_STAGE(PG8_SB(1, 0), b3, voffB); PG8_STAGE(PG8_SB(1, 1), b3 + hstep, voffB); PG8_STAGE(PG8_SA(1, 0), a3, voffA);
            PG8_WAIT_V(8); PG8_WAIT_L(0); PG8_BAR; PG8_MMA(1, 0, At, B0); PG8_MMA(1, 1, At, B1); PG8_BAR; PG8_SCHED;
            } else {
            PG8_LDB(B0, 0, 0); PG8_SCHED; PG8_LDA(At, 0, 0); PG8_STAGE(PG8_SA(1, 1), a1 + hstep, voffA);
            PG8_WAIT_L(8); PG8_BAR; PG8_WAIT_L(0); PG8_MMA(0, 0, At, B0); PG8_BAR; PG8_SCHED;
            PG8_LDB(B1, 0, 1); PG8_STAGE(PG8_SB(0, 0), b2, voffB);
            PG8_BAR; PG8_WAIT_L(0); PG8_MMA(0, 1, At, B1); PG8_BAR;
            PG8_LDA(At, 0, 1); PG8_STAGE(PG8_SA(0, 0), a2, voffA);
            PG8_BAR; PG8_WAIT_L(0); PG8_MMA(1, 0, At, B0); PG8_BAR; PG8_SCHED;
            PG8_STAGE(PG8_SB(0, 1), b2 + hstep, voffB);
            PG8_WAIT_V(6); PG8_BAR; PG8_MMA(1, 1, At, B1); PG8_BAR;
            PG8_LDB(B0, 1, 0); PG8_SCHED; PG8_LDA(At, 1, 0); PG8_STAGE(PG8_SA(0, 1), a2 + hstep, voffA);
            PG8_WAIT_L(8); PG8_BAR; PG8_WAIT_L(0); PG8_MMA(0, 0, At, B0); PG8_BAR; PG8_SCHED;
            PG8_LDB(B1, 1, 1); PG8_STAGE(PG8_SB(1, 0), b3, voffB);
            PG8_BAR; PG8_WAIT_L(0); PG8_MMA(0, 1, At, B1); PG8_BAR;
            PG8_LDA(At, 1, 1); PG8_STAGE(PG8_SA(1, 0), a3, voffA);
            PG8_BAR; PG8_WAIT_L(0); PG8_MMA(1, 0, At, B0); PG8_BAR; PG8_SCHED;
            PG8_STAGE(PG8_SB(1, 1), b3 + hstep, voffB);
            PG8_WAIT_V(6); PG8_BAR; PG8_MMA(1, 1, At, B1); PG8_BAR;
            }
        }
        if constexpr (ALIGN_EPI) { if (wr == 0) PG8_BAR; }
        if constexpr (!Epi::AFTER_DRAIN) { E(acc, cur, wr, wc, fr, fq); S.done(cur); }
        if (!has_next) break;
#pragma unroll
        for (int a = 0; a < 2; ++a)
#pragma unroll
            for (int b = 0; b < 2; ++b)
#pragma unroll
                for (int m = 0; m < 4; ++m)
#pragma unroll
                    for (int n = 0; n < 2; ++n) acc[a][b][m][n] = (f32x4){0.f, 0.f, 0.f, 0.f};
        cur = nxt; cA = nA; cB = nB; ++ui;
        if constexpr (ALIGN_EPI) { if (wr == 1) PG8_BAR; }
    }
    PG8_WAIT_V(0);
    if constexpr (!ALIGN_EPI) { if (wr == 0) PG8_BAR; }
    PG8_BAR;
    if constexpr (Epi::AFTER_DRAIN) { E.fused(acc, cur, wr, wc, fr, fq, lds, wid, lane); S.done(cur); }
#undef PG8_SA
#undef PG8_SB
#undef PG8_STAGE
#undef PG8_LDA
#undef PG8_LDB
#undef PG8_MMA
#undef PG8_WAIT_V
#undef PG8_WAIT_L
#undef PG8_BAR
#undef PG8_SCHED
}
}

constexpr int NWAVES = 8, NTHR = 512;
constexpr int NB = 8, NT = 2048, DM = 1024, M = NB * NT, NL = 4;
constexpr int RW = 512, NH = 8, INW = 2816, NP = 3328, FF = 2816, NGU = 2 * FF;
constexpr int C_R = 0, C_K = 512, C_V = 1024, C_SCB = 1536, C_SCC = 1792, C_SCU = 2048, C_CFV = 2304, C_CFG = 2560;
constexpr int C_PW = 2816, C_PA = 2880, C_PG = 2944, C_QW = 3072, C_QA = 3136, C_QG = 3200;
constexpr float NORM_EPS = 1e-6f, LN_EPS = 1e-5f, GN_EPS = 64e-5f;

enum { I_X = 0, I_WIN, I_MURKV, I_MUWAG, I_W0, I_W1, I_W2, I_A0, I_A1, I_A2, I_G1, I_G2, I_KK, I_KA, I_RK, I_LNXG, I_LNXB, I_SCW, I_CFW, I_CFB, I_CFLG, I_CFLB,
       I_WO, I_WGATE, I_WUP, I_WDOWN, I_PREMIX, I_POSTMIX, I_PREFFN, I_POSTFFN, N_IN };

constexpr size_t MiB = 1u << 20;
constexpr size_t WS_CTL = 0, CTL_ZERO_BYTES = 64 * 1024;
constexpr size_t WS_WIN = 1 * MiB;
constexpr size_t WS_WO = WS_WIN + (size_t)NP * DM * 2;
constexpr size_t WS_WGU = WS_WO + (size_t)DM * DM * 2;
constexpr size_t WS_WDN = WS_WGU + (size_t)NGU * DM * 2;
constexpr size_t WS_HA = 27 * MiB;
constexpr size_t WS_HB = 59 * MiB;
constexpr size_t WS_PROJ = 91 * MiB;
constexpr size_t WS_X1 = 195 * MiB;
constexpr size_t WS_BON = 259 * MiB;
constexpr size_t WS_END = WS_BON + (size_t)M * 8 * 4;
static_assert(WS_WDN + (size_t)DM * FF * 2 <= WS_HA, "weights fit");
static_assert(WS_PROJ + (size_t)M * NP * 2 <= WS_X1, "proj fits");

#define GAS __attribute__((address_space(1)))
#define LAS __attribute__((address_space(3)))
typedef unsigned short bf16;
typedef unsigned v4u __attribute__((ext_vector_type(4)));
typedef unsigned v2u __attribute__((ext_vector_type(2)));
typedef float f32x4 __attribute__((ext_vector_type(4)));
typedef GAS unsigned gu32;
#define LDS_WAIT() asm volatile("s_waitcnt lgkmcnt(0)" ::: "memory")

__device__ __forceinline__ unsigned f2bf(float f) { unsigned u = __builtin_bit_cast(unsigned, f); return (u + 0x7fffu + ((u >> 16) & 1u)) >> 16; }
__device__ __forceinline__ unsigned pk2(float lo, float hi) { return f2bf(lo) | (f2bf(hi) << 16); }
__device__ __forceinline__ float bf2f(unsigned short u) { return __builtin_bit_cast(float, (unsigned)u << 16); }
__device__ __forceinline__ float bflo(unsigned u) { return __builtin_bit_cast(float, u << 16); }
__device__ __forceinline__ float bfhi(unsigned u) { return __builtin_bit_cast(float, u & 0xffff0000u); }
__device__ __forceinline__ float sigmoidf_(float x) { return 1.0f / (1.0f + __expf(-x)); }

__device__ __forceinline__ float wave_sum(float v) {
#pragma unroll
    for (int o = 1; o < 64; o <<= 1) v += __shfl_xor(v, o);
    return v;
}
template <int CTRL> __device__ __forceinline__ float dpp_mov(float x) { return __builtin_bit_cast(float, __builtin_amdgcn_update_dpp(0, __builtin_bit_cast(int, x), CTRL, 0xf, 0xf, true)); }
__device__ __forceinline__ float allreduce16(float x) {
    x += dpp_mov<0xB1>(x);
    x += dpp_mov<0x4E>(x);
    x += dpp_mov<0x141>(x);
    x += dpp_mov<0x140>(x);
    return x;
}

#define XB_TMO      128
#define XB_XCNT(j)  (256  + 64 * (j))
#define XB_XSUB(j)  (1280 + 64 * (j))
#define XB_XGEN(j)  (2304 + 64 * (j))
#define XB_TOP      3328
#define XB_TOPGEN   3392
#define XCD_BAR_WORDS 3456
#define XB_SPIN_CAP (1u << 18)
__device__ __forceinline__ unsigned xb_ld(unsigned* p)              { return __hip_atomic_load(p, __ATOMIC_RELAXED, __HIP_MEMORY_SCOPE_AGENT); }
__device__ __forceinline__ unsigned xb_add(unsigned* p, unsigned v) { return __hip_atomic_fetch_add(p, v, __ATOMIC_RELAXED, __HIP_MEMORY_SCOPE_AGENT); }
__device__ __forceinline__ unsigned xb_xcc_id() { return (unsigned)__builtin_amdgcn_s_getreg((3 << 11) | 20) & 0xFu; }
#define XB_SPIN(cond, bar) do { unsigned _sp = 0; while (cond) { __builtin_amdgcn_s_sleep(1); \
    if ((++_sp & 255u) == 0u) { if (xb_ld(&(bar)[XB_TMO])) break; if (_sp > XB_SPIN_CAP) { atomicAdd(&(bar)[XB_TMO], 1u); break; } } } } while (0)
struct XcdBarrier { unsigned* bar; unsigned x; volatile LAS unsigned* st; };
__device__ __forceinline__ XcdBarrier xcd_barrier_post(unsigned* bar, volatile LAS unsigned* st) {
    XcdBarrier b; b.bar = bar; b.x = xb_xcc_id(); b.st = st;
    if (threadIdx.x == 0) (void)xb_add(&bar[XB_XCNT(b.x)], 1u);
    return b;
}
__device__ __forceinline__ void xcd_barrier_complete(unsigned* bar, unsigned x, unsigned& nloc, unsigned& nx) {
    const unsigned G = gridDim.x * gridDim.y * gridDim.z;
    unsigned sum, cnt, mine, sp = 0u;
    for (;;) {
        sum = 0u; cnt = 0u; mine = 0u;
#pragma unroll
        for (unsigned j = 0; j < 16; ++j) { const unsigned c = xb_ld(&bar[XB_XCNT(j)]); sum += c; cnt += (c > 0u) ? 1u : 0u; mine = (j == x) ? c : mine; }
        if (sum == G) break;
        __builtin_amdgcn_s_sleep(1);
        if ((++sp & 255u) == 0u) { if (xb_ld(&bar[XB_TMO])) break; if (sp > XB_SPIN_CAP) { atomicAdd(&bar[XB_TMO], 1u); break; } }
    }
    nloc = mine > 0u ? mine : 1u; nx = cnt > 0u ? cnt : 1u;
}
__device__ __forceinline__ void xcd_barrier(const XcdBarrier& b) {
    asm volatile("s_waitcnt vmcnt(0)" ::: "memory");
    __syncthreads();
    if (threadIdx.x == 0) {
        unsigned* bar = b.bar;
        __builtin_amdgcn_s_waitcnt(0);
        unsigned nloc = b.st[0], nx = b.st[1];
        if (nloc == 0u) { xcd_barrier_complete(bar, b.x, nloc, nx); b.st[0] = nloc; b.st[1] = nx; }
        const unsigned old = xb_add(&bar[XB_XSUB(b.x)], 1u);
        const unsigned gen = old / nloc;
        if (old + 1u == (gen + 1u) * nloc) {
            __builtin_amdgcn_fence(__ATOMIC_RELEASE, "agent");
            asm volatile("s_waitcnt vmcnt(0)" ::: "memory");
            const unsigned og = xb_add(&bar[XB_TOP], 1u);
            const unsigned tg = og / nx;
            if (og + 1u == (tg + 1u) * nx) xb_add(&bar[XB_TOPGEN], 1u);
            else XB_SPIN(xb_ld(&bar[XB_TOPGEN]) == tg, bar);
            __builtin_amdgcn_fence(__ATOMIC_ACQUIRE, "agent");
            xb_add(&bar[XB_XGEN(b.x)], 1u);
            asm volatile("s_waitcnt vmcnt(0)" ::: "memory");
        } else {
            XB_SPIN(xb_ld(&bar[XB_XGEN(b.x)]) == gen, bar);
            __builtin_amdgcn_fence(__ATOMIC_ACQUIRE, "agent");
            asm volatile("s_waitcnt vmcnt(0)" ::: "memory");
        }
    }
    __syncthreads();
}

constexpr int RING_BYTES = 131072, MISC_OFF = RING_BYTES + 320, LDS_BYTES = 147456;

struct Args { const float* in[N_IN]; float* out; unsigned char* ws; int ph_lo, ph_hi; };

struct Frame {
    LAS unsigned char* lds;
    int tid, lane, wave, blk, G;
    const float* const* in; float* out; unsigned char* ws;
};

__device__ __forceinline__ void transpose_item(const float* W, int K, int N, bf16* WT, int dst_row0, int k0, int n0, const float* s, int mode, LAS float* scr, int lane) {
#pragma unroll 8
    for (int i = 0; i < 32; ++i) { const int kk = 2 * i + (lane >> 5); float v = W[(size_t)(k0 + kk) * N + n0 + (lane & 31)];
        if (mode) { const float sv = s[k0 + kk]; v *= (mode == 1) ? sv : (1.0f - sv); }
        scr[kk * 33 + (lane & 31)] = v; }
    LDS_WAIT(); asm volatile("" ::: "memory");
    const int c = lane & 7;
#pragma unroll
    for (int j = 0; j < 4; ++j) { const int n = (lane >> 3) + 8 * j; const LAS float* p = scr + (8 * c) * 33 + n;
        v4u o; o.x = pk2(p[0 * 33], p[1 * 33]); o.y = pk2(p[2 * 33], p[3 * 33]); o.z = pk2(p[4 * 33], p[5 * 33]); o.w = pk2(p[6 * 33], p[7 * 33]);
        *(GAS v4u*)(WT + (size_t)(dst_row0 + n) * K + k0 + 8 * c) = o; }
    LDS_WAIT(); asm volatile("" ::: "memory");
}
__device__ __forceinline__ void phase_conv(const Frame& F, int l) {
    LAS float* scr = (LAS float*)(F.lds + F.wave * 16384);
    const int gw = F.blk * NWAVES + F.wave, NGW = F.G * NWAVES;
    bf16* WIN = (bf16*)(F.ws + WS_WIN); bf16* WO = (bf16*)(F.ws + WS_WO); bf16* WGU = (bf16*)(F.ws + WS_WGU); bf16* WDN = (bf16*)(F.ws + WS_WDN);
    constexpr int I_IN = 16 * 88, I_LORA = 256, I_O = 16 * 32, I_G = 16 * 88, I_D = 44 * 32;
    constexpr int NITEMS = I_IN + I_LORA + I_O + 2 * I_G + I_D;
    const float* mu = F.in[I_MUWAG] + (size_t)l * 3 * DM;
    for (int it = gw; it < NITEMS; it += NGW) {
        int r = it;
        if (r < I_IN) { const int kb = r / 88, nb = r % 88; transpose_item(F.in[I_WIN] + (size_t)l * DM * INW, DM, INW, WIN, 32 * nb, 64 * kb, 32 * nb, nullptr, 0, scr, F.lane); continue; } r -= I_IN;
        if (r < I_LORA) {
            int sub, rr;
            if (r < 128) { sub = r / 32; rr = r % 32; } else { sub = 4 + (r - 128) / 64; rr = (r - 128) % 64; }
            const int which = sub >> 1, isq = sub & 1, Nn = (which == 2) ? 128 : 64, nblk = Nn / 32, kb = rr / nblk, nb = rr % nblk;
            const float* W = (which == 0 ? F.in[I_W1] : which == 1 ? F.in[I_A1] : F.in[I_G1]) + (size_t)l * DM * Nn;
            const int dst = (which == 0 ? (isq ? C_QW : C_PW) : which == 1 ? (isq ? C_QA : C_PA) : (isq ? C_QG : C_PG)) + 32 * nb;
            transpose_item(W, DM, Nn, WIN, dst, 64 * kb, 32 * nb, mu + which * DM, isq ? 1 : 2, scr, F.lane); continue; } r -= I_LORA;
        if (r < I_O) { const int kb = r / 32, nb = r % 32; transpose_item(F.in[I_WO] + (size_t)l * DM * DM, DM, DM, WO, 32 * nb, 64 * kb, 32 * nb, nullptr, 0, scr, F.lane); continue; } r -= I_O;
        if (r < 2 * I_G) { const int up = r / I_G, q = r % I_G, kb = q / 88, nb = q % 88, n0 = 32 * nb;
            const float* W = (up ? F.in[I_WUP] : F.in[I_WGATE]) + (size_t)l * DM * FF;
            transpose_item(W, DM, FF, WGU, (n0 / 128) * 256 + (n0 % 128) + up * 128, 64 * kb, n0, nullptr, 0, scr, F.lane); continue; } r -= 2 * I_G;
        { const int kb = r / 32, nb = r % 32; transpose_item(F.in[I_WDOWN] + (size_t)l * FF * DM, FF, DM, WDN, 32 * nb, 64 * kb, 32 * nb, nullptr, 0, scr, F.lane); }
    }
}

__device__ __forceinline__ void store_row_bf16(bf16* orow, const f32x4 (&v)[4], float r, const float* g, int lane) {
    GAS unsigned long long* o8 = (GAS unsigned long long*)orow + lane;
#pragma unroll
    for (int j = 0; j < 4; ++j) { const f32x4 gg = *(const f32x4*)(g + 4 * lane + 256 * j);
        o8[64 * j] = (unsigned long long)pk2(v[j].x * r * gg.x, v[j].y * r * gg.y) | ((unsigned long long)pk2(v[j].z * r * gg.z, v[j].w * r * gg.w) << 32); }
}
__device__ __forceinline__ float row_sumsq(const f32x4 (&v)[4]) {
    float s = 0.f;
#pragma unroll
    for (int j = 0; j < 4; ++j) s += (v[j].x * v[j].x + v[j].y * v[j].y) + (v[j].z * v[j].z + v[j].w * v[j].w);
    return wave_sum(s);
}
__device__ __forceinline__ void phase_norm0(const Frame& F) {
    const int gw = F.blk * NWAVES + F.wave, NGW = F.G * NWAVES;
    bf16* H = (bf16*)(F.ws + WS_HA); const float* g = F.in[I_PREMIX];
    for (int m = gw; m < M; m += NGW) {
        const GAS f32x4* xr = (const GAS f32x4*)(F.in[I_X] + (size_t)m * DM) + F.lane;
        f32x4 v[4];
#pragma unroll
        for (int j = 0; j < 4; ++j) v[j] = xr[64 * j];
        const float r = rsqrtf(row_sumsq(v) * (1.f / DM) + NORM_EPS);
        store_row_bf16(H + (size_t)m * DM, v, r, g, F.lane);
    }
}
__device__ __forceinline__ void phase_norm_res(const Frame& F, const float* tmp, const float* xold, const float* g1, const float* g2) {
    const int gw = F.blk * NWAVES + F.wave, NGW = F.G * NWAVES;
    bf16* H = (bf16*)(F.ws + WS_HA);
    for (int m = gw; m < M; m += NGW) {
        const GAS f32x4* tr = (const GAS f32x4*)(tmp + (size_t)m * DM) + F.lane;
        const GAS f32x4* xr = (const GAS f32x4*)(xold + (size_t)m * DM) + F.lane;
        GAS f32x4* orow = (GAS f32x4*)(F.out + (size_t)m * DM) + F.lane;
        f32x4 v[4], x[4];
#pragma unroll
        for (int j = 0; j < 4; ++j) { v[j] = tr[64 * j]; x[j] = xr[64 * j]; }
        const float r = rsqrtf(row_sumsq(v) * (1.f / DM) + NORM_EPS);
#pragma unroll
        for (int j = 0; j < 4; ++j) { const f32x4 gg = *(const f32x4*)(g1 + 4 * F.lane + 256 * j); x[j] = x[j] + v[j] * r * gg; orow[64 * j] = x[j]; }
        if (g2) { const float r2 = rsqrtf(row_sumsq(x) * (1.f / DM) + NORM_EPS); store_row_bf16(H + (size_t)m * DM, x, r2, g2, F.lane); }
    }
}

__device__ __forceinline__ void phase_prep(const Frame& F, int l) {
    LAS float* lin = (LAS float*)F.lds;
    const int c = F.tid, hh = F.wave;
    const bf16* PROJ = (const bf16*)(F.ws + WS_PROJ);
    _Float16* LW = (_Float16*)(F.ws + WS_X1); bf16* KP = (bf16*)(F.ws + WS_X1 + 16 * MiB); bf16* KK = (bf16*)(F.ws + WS_X1 + 32 * MiB); bf16* BV = (bf16*)(F.ws + WS_X1 + 48 * MiB);
    bf16* RR = (bf16*)(F.ws + WS_HA + 16 * MiB); float* BON = (float*)(F.ws + WS_BON);
    const float w0c = F.in[I_W0][l * RW + c], a0c = F.in[I_A0][l * RW + c], kkc = F.in[I_KK][l * RW + c], kac = F.in[I_KA][l * RW + c], rkc = F.in[I_RK][l * RW + c];
    const float mur = F.in[I_MURKV][l * 3 * RW + c], muk = F.in[I_MURKV][l * 3 * RW + RW + c];
    float W2r[64], A2r[64];
#pragma unroll
    for (int j = 0; j < 64; ++j) { W2r[j] = F.in[I_W2][((size_t)l * 64 + j) * RW + c]; A2r[j] = F.in[I_A2][((size_t)l * 64 + j) * RW + c]; }
    for (int tile = F.blk; tile < M / 64; tile += F.G) {
        const int m0 = tile * 64;
        float rprev = 0.f, kprev = 0.f;
        if ((m0 % NT) != 0) { rprev = bf2f(PROJ[(size_t)(m0 - 1) * NP + C_R + c]); kprev = bf2f(PROJ[(size_t)(m0 - 1) * NP + C_K + c]); }
        for (int i = 0; i < 64; ++i) {
            const int m = m0 + i, t = m % NT, buf = (i & 1) * 128;
            if (c < 128) { const int j = c & 63, which = c >> 6;
                const float p = bf2f(PROJ[(size_t)m * NP + (which ? C_PA : C_PW) + j]);
                const float q = t > 0 ? bf2f(PROJ[(size_t)(m - 1) * NP + (which ? C_QA : C_QW) + j]) : 0.f;
                lin[buf + c] = which ? (p + q) : tanhf(p + q); }
            const float rp = bf2f(PROJ[(size_t)m * NP + C_R + c]), kp_ = bf2f(PROJ[(size_t)m * NP + C_K + c]);
            __syncthreads();
            float wp = w0c, ap = a0c;
#pragma unroll
            for (int j = 0; j < 64; j += 4) { const f32x4 lw4 = *(const LAS f32x4*)(lin + buf + j), la4 = *(const LAS f32x4*)(lin + buf + 64 + j);
                wp += lw4.x * W2r[j] + lw4.y * W2r[j + 1] + lw4.z * W2r[j + 2] + lw4.w * W2r[j + 3];
                ap += la4.x * A2r[j] + la4.y * A2r[j + 1] + la4.z * A2r[j + 2] + la4.w * A2r[j + 3]; }
            const float a = sigmoidf_(ap), lwv = -0.60653065971f * sigmoidf_(wp);
            const float r = rp + (rprev - rp) * mur, k = kp_ + (kprev - kp_) * muk;
            rprev = rp; kprev = kp_;
            const float kku = k * kkc, n2 = wave_sum(kku * kku);
            const float kk = kku / fmaxf(sqrtf(n2), 1e-12f);
            const float kpr = k * (1.0f + (a - 1.0f) * kac), bvv = kk * a;
            const float bon = wave_sum(r * kpr * rkc);
            const size_t o = (size_t)m * RW + c;
            LW[o] = (_Float16)lwv; KP[o] = (bf16)f2bf(kpr); KK[o] = (bf16)f2bf(kk); BV[o] = (bf16)f2bf(bvv); RR[o] = (bf16)f2bf(r);
            if (F.lane == 0) BON[(size_t)m * NH + hh] = bon;
        }
        __syncthreads();
    }
}

__device__ __forceinline__ void phase_scan(const Frame& F, int l) {
    if (F.wave >= 4) return;
    const bf16* PROJ = (const bf16*)(F.ws + WS_PROJ);
    const _Float16* LW = (const _Float16*)(F.ws + WS_X1); const bf16* KP = (const bf16*)(F.ws + WS_X1 + 16 * MiB); const bf16* KK = (const bf16*)(F.ws + WS_X1 + 32 * MiB); const bf16* BV = (const bf16*)(F.ws + WS_X1 + 48 * MiB);
    const bf16* RR = (const bf16*)(F.ws + WS_HA + 16 * MiB); bf16* Y = (bf16*)(F.ws + WS_HA);
    for (int item = F.blk; item < NB * NH * 4; item += F.G) {
        const int bh = item >> 2, rb = item & 3, b = bh >> 3, h = bh & 7;
        const int i = 16 * rb + 4 * F.wave + (F.lane >> 4), cg = F.lane & 15, ch = h * 64;
        const float muv = F.in[I_MURKV][l * 3 * RW + 2 * RW + ch + i];
        const size_t mb = (size_t)b * NT;
        const size_t cofs = ch + 4 * cg;
        float S0 = 0.f, S1 = 0.f, S2 = 0.f, S3 = 0.f, vprev = 0.f;
        for (int t0 = 0; t0 < NT; t0 += 8) {
            typedef _Float16 h4 __attribute__((ext_vector_type(4)));
            v2u kkr[8], bvr[8], kpr[8], rrr[8]; h4 lwr[8]; unsigned short vr[8];
#pragma unroll
            for (int s = 0; s < 8; ++s) { const size_t m = mb + t0 + s, o = m * RW + cofs;
                kkr[s] = *(const GAS v2u*)(KK + o); bvr[s] = *(const GAS v2u*)(BV + o); kpr[s] = *(const GAS v2u*)(KP + o); rrr[s] = *(const GAS v2u*)(RR + o);
                lwr[s] = *(const GAS h4*)(LW + o); vr[s] = PROJ[m * NP + C_V + ch + i]; }
#pragma unroll
            for (int s = 0; s < 8; ++s) {
                const float k0 = bflo(kkr[s].x), k1 = bfhi(kkr[s].x), k2 = bflo(kkr[s].y), k3 = bfhi(kkr[s].y);
                const float b0 = bflo(bvr[s].x), b1 = bfhi(bvr[s].x), b2 = bflo(bvr[s].y), b3 = bfhi(bvr[s].y);
                const float p0 = bflo(kpr[s].x), p1 = bfhi(kpr[s].x), p2 = bflo(kpr[s].y), p3 = bfhi(kpr[s].y);
                const float r0 = bflo(rrr[s].x), r1 = bfhi(rrr[s].x), r2 = bflo(rrr[s].y), r3 = bfhi(rrr[s].y);
                const float w0 = __expf((float)lwr[s].x), w1 = __expf((float)lwr[s].y), w2 = __expf((float)lwr[s].z), w3 = __expf((float)lwr[s].w);
                const float vc = bf2f(vr[s]); const float v = vc + (vprev - vc) * muv; vprev = vc;
                const float sa = -allreduce16((S0 * k0 + S1 * k1) + (S2 * k2 + S3 * k3));
                S0 = S0 * w0 + (sa * b0 + v * p0); S1 = S1 * w1 + (sa * b1 + v * p1); S2 = S2 * w2 + (sa * b2 + v * p2); S3 = S3 * w3 + (sa * b3 + v * p3);
                const float y = allreduce16((S0 * r0 + S1 * r1) + (S2 * r2 + S3 * r3));
                if (cg == 0) Y[(mb + t0 + s) * RW + ch + i] = (bf16)f2bf(y);
            }
        }
    }
}


__device__ __forceinline__ void phase_scan_simple(const Frame& F, int l) {
    if (F.wave >= 1 || F.blk >= NB * NH) return;
    LAS float* sh = (LAS float*)F.lds;
    const bf16* PROJ = (const bf16*)(F.ws + WS_PROJ);
    const _Float16* LW = (const _Float16*)(F.ws + WS_X1); const bf16* KP = (const bf16*)(F.ws + WS_X1 + 16 * MiB); const bf16* KK = (const bf16*)(F.ws + WS_X1 + 32 * MiB); const bf16* BV = (const bf16*)(F.ws + WS_X1 + 48 * MiB);
    const bf16* RR = (const bf16*)(F.ws + WS_HA + 16 * MiB); bf16* Y = (bf16*)(F.ws + WS_HA);
    const int b = F.blk >> 3, h = F.blk & 7, lane = F.lane, c = h * 64 + lane;
    const float muv = F.in[I_MURKV][l * 3 * RW + 2 * RW + c];
    float S[64];
#pragma unroll
    for (int j = 0; j < 64; ++j) S[j] = 0.f;
    float vprev = 0.f;
    for (int t = 0; t < NT; ++t) {
        const size_t m = (size_t)b * NT + t, o = m * RW + c;
        sh[lane] = __expf((float)LW[o]); sh[64 + lane] = bf2f(KK[o]); sh[128 + lane] = bf2f(BV[o]); sh[192 + lane] = bf2f(KP[o]); sh[256 + lane] = bf2f(RR[o]);
        const float vc = bf2f(PROJ[m * NP + C_V + c]); const float v = vc + (vprev - vc) * muv; vprev = vc;
        LDS_WAIT(); asm volatile("" ::: "memory");
        float sa = 0.f;
#pragma unroll
        for (int j = 0; j < 64; ++j) sa -= S[j] * sh[64 + j];
        float y = 0.f;
#pragma unroll
        for (int j = 0; j < 64; ++j) { S[j] = S[j] * sh[j] + sa * sh[128 + j] + v * sh[192 + j]; y += S[j] * sh[256 + j]; }
        Y[o] = (bf16)f2bf(y);
        LDS_WAIT(); asm volatile("" ::: "memory");
    }
}
__device__ __forceinline__ void phase_post(const Frame& F, int l) {
    LAS float* lin = (LAS float*)F.lds;
    const int c = F.tid, hh = F.wave;
    const bf16* PROJ = (const bf16*)(F.ws + WS_PROJ); const bf16* Y = (const bf16*)(F.ws + WS_HA); const float* BON = (const float*)(F.ws + WS_BON);
    bf16* MIX = (bf16*)(F.ws + WS_HB);
    const float lg_ = F.in[I_LNXG][l * RW + c], lb_ = F.in[I_LNXB][l * RW + c], muv = F.in[I_MURKV][l * 3 * RW + 2 * RW + c];
    int hhv = c >> 6; asm volatile("" : "+v"(hhv));
    float G2r[128];
#pragma unroll
    for (int j = 0; j < 128; ++j) G2r[j] = F.in[I_G2][((size_t)l * 128 + j) * RW + c];
    for (int tile = F.blk; tile < M / 64; tile += F.G) {
        const int m0 = tile * 64;
        float vprev = 0.f;
        if ((m0 % NT) != 0) vprev = bf2f(PROJ[(size_t)(m0 - 1) * NP + C_V + c]);
        for (int i = 0; i < 64; ++i) {
            const int m = m0 + i, t = m % NT, buf = (i & 1) * 128;
            if (c < 128) { const float p = bf2f(PROJ[(size_t)m * NP + C_PG + c]); const float q = t > 0 ? bf2f(PROJ[(size_t)(m - 1) * NP + C_QG + c]) : 0.f; lin[buf + c] = sigmoidf_(p + q); }
            const float vc = bf2f(PROJ[(size_t)m * NP + C_V + c]); const float y = bf2f(Y[(size_t)m * RW + c]); const float bon = BON[(size_t)m * NH + hhv];
            __syncthreads();
            float g = 0.f;
#pragma unroll
            for (int j = 0; j < 128; j += 4) { const f32x4 l4 = *(const LAS f32x4*)(lin + buf + j); g += l4.x * G2r[j] + l4.y * G2r[j + 1] + l4.z * G2r[j + 2] + l4.w * G2r[j + 3]; }
            const float v = vc + (vprev - vc) * muv; vprev = vc;
            const float mean = wave_sum(y) * (1.f / 64.f), d = y - mean, var = wave_sum(d * d) * (1.f / 64.f);
            const float yn = d * rsqrtf(var + GN_EPS) * lg_ + lb_ + bon * v;
            MIX[(size_t)m * DM + c] = (bf16)f2bf(yn * g);
        }
        __syncthreads();
    }
}
__device__ __forceinline__ void phase_sc(const Frame& F, int l) {
    const bf16* PROJ = (const bf16*)(F.ws + WS_PROJ); bf16* MIX = (bf16*)(F.ws + WS_HB);
    const int c = F.tid & 255, sub = F.tid >> 8;
    const float w0 = F.in[I_SCW][(l * 3 + 0) * 256 + c], w1 = F.in[I_SCW][(l * 3 + 1) * 256 + c], w2 = F.in[I_SCW][(l * 3 + 2) * 256 + c];
    for (int m = F.blk * 2 + sub; m < M; m += F.G * 2) {
        const int t = m % NT; const bf16* p = PROJ + (size_t)m * NP;
        float acc = w2 * bf2f(p[C_SCC + c]) * bf2f(p[C_SCU + c]);
        if (t >= 1) acc += w1 * bf2f(p[C_SCC + c - NP]) * bf2f(p[C_SCU + c - NP]);
        if (t >= 2) acc += w0 * bf2f(p[C_SCC + c - 2 * NP]) * bf2f(p[C_SCU + c - 2 * NP]);
        MIX[(size_t)m * DM + 512 + c] = (bf16)f2bf(bf2f(p[C_SCB + c]) * acc);
    }
}
__device__ __forceinline__ void phase_cf(const Frame& F, int l) {
    const bf16* PROJ = (const bf16*)(F.ws + WS_PROJ); bf16* MIX = (bf16*)(F.ws + WS_HB);
    LAS float* U = (LAS float*)F.lds;
    LAS float* CT = (LAS float*)(F.lds + 62 * 256 * 4);
    const int c = F.tid & 255, half = F.tid >> 8;
    float wr[31];
#pragma unroll
    for (int k = 0; k < 31; ++k) wr[k] = F.in[I_CFW][((size_t)l * 31 + k) * 256 + c];
    const float cb = F.in[I_CFB][l * 256 + c];
    const f32x4 lng = *(const f32x4*)(F.in[I_CFLG] + l * 256 + 4 * F.lane), lnb = *(const f32x4*)(F.in[I_CFLB] + l * 256 + 4 * F.lane);
    for (int tile = F.blk; tile < M / 32; tile += F.G) {
        const int m0 = tile * 32, t0 = m0 % NT;
        for (int idx = F.tid; idx < 62 * 256; idx += NTHR) { const int rr = idx >> 8, cc = idx & 255; const int tt = t0 - 30 + rr;
            float u = 0.f;
            if (tt >= 0) { const bf16* p = PROJ + (size_t)(m0 - 30 + rr) * NP; u = bf2f(p[C_CFV + cc]) * sigmoidf_(bf2f(p[C_CFG + cc])); }
            U[idx] = u; }
        __syncthreads();
#pragma unroll 1
        for (int ii = 0; ii < 16; ++ii) { const int i = half * 16 + ii; float acc = cb;
#pragma unroll
            for (int k = 0; k < 31; ++k) acc += wr[k] * U[(i + k) * 256 + c];
            CT[i * 256 + c] = acc; }
        __syncthreads();
#pragma unroll 1
        for (int q = 0; q < 4; ++q) { const int i = F.wave * 4 + q;
            const f32x4 x = *(const LAS f32x4*)(CT + i * 256 + 4 * F.lane);
            const float mean = wave_sum((x.x + x.y) + (x.z + x.w)) * (1.f / 256.f);
            const f32x4 d = x - mean;
            const float var = wave_sum((d.x * d.x + d.y * d.y) + (d.z * d.z + d.w * d.w)) * (1.f / 256.f);
            const float rs = rsqrtf(var + LN_EPS);
            f32x4 y = d * rs * lng + lnb;
            y.x = y.x * sigmoidf_(y.x); y.y = y.y * sigmoidf_(y.y); y.z = y.z * sigmoidf_(y.z); y.w = y.w * sigmoidf_(y.w);
            *(GAS unsigned long long*)(MIX + (size_t)(m0 + i) * DM + 768 + 4 * F.lane) = (unsigned long long)pk2(y.x, y.y) | ((unsigned long long)pk2(y.z, y.w) << 32); }
        __syncthreads();
    }
}

#if DIAG
#ifndef DIAG_L
#define DIAG_L 0
#endif
__device__ __forceinline__ void diag_acc(unsigned char* ws, int id, float num, float den) {
    float* D = (float*)(ws + WS_CTL + 32768);
    num = wave_sum(num); den = wave_sum(den);
    if ((threadIdx.x & 63) == 0) { atomicAdd(D + 2 * id, num); atomicAdd(D + 2 * id + 1, den); }
}
__device__ __forceinline__ float dg_lora_w(const Args& a, int l, int k, int c) {
    int q = c - C_PW; const int isq = q >= 256; q -= isq * 256;
    const int which = q < 64 ? 0 : q < 128 ? 1 : 2, j = which == 0 ? q : which == 1 ? q - 64 : q - 128, Nn = which == 2 ? 128 : 64;
    const float* W = (which == 0 ? a.in[I_W1] : which == 1 ? a.in[I_A1] : a.in[I_G1]) + (size_t)l * DM * Nn;
    const float mu = a.in[I_MUWAG][(size_t)l * 3 * DM + which * DM + k];
    return W[(size_t)k * Nn + j] * (isq ? mu : 1.0f - mu);
}
__global__ void __launch_bounds__(512) diag_proj(Args a, int l) {
    __shared__ float hrow[DM];
    const int m = blockIdx.x * 257, tid = threadIdx.x;
    const bf16* HA = (const bf16*)(a.ws + WS_HA); const bf16* PROJ = (const bf16*)(a.ws + WS_PROJ);
    for (int k = tid; k < DM; k += 512) hrow[k] = bf2f(HA[(size_t)m * DM + k]);
    __syncthreads();
    float n0 = 0.f, d0 = 0.f, n1 = 0.f, d1 = 0.f;
    for (int c = tid; c < NP; c += 512) {
        float ref = 0.f;
        if (c < INW) { const float* W = a.in[I_WIN] + (size_t)l * DM * INW + c; for (int k = 0; k < DM; ++k) ref += hrow[k] * W[(size_t)k * INW]; }
        else for (int k = 0; k < DM; ++k) ref += hrow[k] * dg_lora_w(a, l, k, c);
        const float got = bf2f(PROJ[(size_t)m * NP + c]), e = ref - got;
        if (c < INW) { n0 += e * e; d0 += ref * ref; } else { n1 += e * e; d1 += ref * ref; }
    }
    diag_acc(a.ws, 0, n0, d0); diag_acc(a.ws, 1, n1, d1);
}
__global__ void __launch_bounds__(64) diag_y(Args a, int l) {
    __shared__ float sh[5][64]; __shared__ float sh2[5][64]; __shared__ float lin[128];
    const int b = blockIdx.x, h = blockIdx.x, lane = threadIdx.x, c = h * 64 + lane;
    const bf16* PROJ = (const bf16*)(a.ws + WS_PROJ); const bf16* Y = (const bf16*)(a.ws + WS_HA);
    const float w0c = a.in[I_W0][l * RW + c], a0c = a.in[I_A0][l * RW + c], kkc = a.in[I_KK][l * RW + c], kac = a.in[I_KA][l * RW + c];
    const float mur = a.in[I_MURKV][l * 3 * RW + c], muk = a.in[I_MURKV][l * 3 * RW + RW + c], muv = a.in[I_MURKV][l * 3 * RW + 2 * RW + c];
    float S[64];
#pragma unroll
    for (int j = 0; j < 64; ++j) S[j] = 0.f;
    float rprev = 0.f, kprev = 0.f, vprev = 0.f, num = 0.f, den = 0.f, num2 = 0.f, den2 = 0.f, pn[5] = {0.f, 0.f, 0.f, 0.f, 0.f}, pd[5] = {0.f, 0.f, 0.f, 0.f, 0.f};
    float S2[64];
#pragma unroll
    for (int j = 0; j < 64; ++j) S2[j] = 0.f;
    for (int t = 0; t < NT; ++t) {
        const size_t m = (size_t)b * NT + t; const bf16* p = PROJ + m * NP;
        float pw = bf2f(p[C_PW + lane]), pa = bf2f(p[C_PA + lane]);
        if (t > 0) { pw += bf2f(p[C_QW + lane - NP]); pa += bf2f(p[C_QA + lane - NP]); }
        lin[lane] = tanhf(pw); lin[64 + lane] = pa;
        __syncthreads();
        float wp = w0c, ap = a0c;
        for (int j = 0; j < 64; ++j) { wp += lin[j] * a.in[I_W2][((size_t)l * 64 + j) * RW + c]; ap += lin[64 + j] * a.in[I_A2][((size_t)l * 64 + j) * RW + c]; }
        const float av = 1.f / (1.f + expf(-ap)), w = expf(-0.60653065971f / (1.f + expf(-wp)));
        const float rp = bf2f(p[C_R + c]), kp_ = bf2f(p[C_K + c]), vp = bf2f(p[C_V + c]);
        const float r = rp + (rprev - rp) * mur, k = kp_ + (kprev - kp_) * muk, v = vp + (vprev - vp) * muv;
        rprev = rp; kprev = kp_; vprev = vp;
        const float kku = k * kkc; const float kk = kku / fmaxf(sqrtf(wave_sum(kku * kku)), 1e-12f);
        sh[0][lane] = w; sh[1][lane] = kk; sh[2][lane] = kk * av; sh[3][lane] = k * (1.f + (av - 1.f) * kac); sh[4][lane] = r;
        { const size_t o = m * RW + c;
          const float gw = expf((float)((const _Float16*)(a.ws + WS_X1))[o]), gkp = bf2f(((const bf16*)(a.ws + WS_X1 + 16 * MiB))[o]), gkk = bf2f(((const bf16*)(a.ws + WS_X1 + 32 * MiB))[o]);
          const float gbv = bf2f(((const bf16*)(a.ws + WS_X1 + 48 * MiB))[o]), grr = bf2f(((const bf16*)(a.ws + WS_HA + 16 * MiB))[o]);
          pn[0] += (gw - w) * (gw - w); pd[0] += w * w; pn[1] += (gkk - kk) * (gkk - kk); pd[1] += kk * kk; pn[2] += (gbv - kk * av) * (gbv - kk * av); pd[2] += kk * av * kk * av;
          pn[3] += (gkp - sh[3][lane]) * (gkp - sh[3][lane]); pd[3] += sh[3][lane] * sh[3][lane]; pn[4] += (grr - r) * (grr - r); pd[4] += r * r;
          sh2[0][lane] = gw; sh2[1][lane] = gkk; sh2[2][lane] = gbv; sh2[3][lane] = gkp; sh2[4][lane] = grr; }
        __syncthreads();
        float sa = 0.f;
#pragma unroll
        for (int j = 0; j < 64; ++j) sa -= S[j] * sh[1][j];
        float y = 0.f;
#pragma unroll
        for (int j = 0; j < 64; ++j) { S[j] = S[j] * sh[0][j] + sa * sh[2][j] + v * sh[3][j]; y += S[j] * sh[4][j]; }
        const float got = bf2f(Y[m * RW + c]), e = y - got;
        num += e * e; den += y * y;
        { float sa2 = 0.f;
#pragma unroll
          for (int j = 0; j < 64; ++j) sa2 -= S2[j] * sh2[1][j];
          float y2 = 0.f;
#pragma unroll
          for (int j = 0; j < 64; ++j) { S2[j] = S2[j] * sh2[0][j] + sa2 * sh2[2][j] + v * sh2[3][j]; y2 += S2[j] * sh2[4][j]; }
          num2 += (y2 - got) * (y2 - got); den2 += y2 * y2; }
        __syncthreads();
    }
    diag_acc(a.ws, 2, num, den);
#pragma unroll
    for (int q = 0; q < 5; ++q) diag_acc(a.ws, 12 + q, pn[q], pd[q]);
    diag_acc(a.ws, 17, num2, den2);
}
__global__ void __launch_bounds__(512) diag_mix(Args a, int l) {
    __shared__ float lg[128], la[64], red[16];
    const int m = blockIdx.x * 257 + 40, t = m % NT, c = threadIdx.x, lane = c & 63, wv = c >> 6;
    const bf16* PROJ = (const bf16*)(a.ws + WS_PROJ); const bf16* Y = (const bf16*)(a.ws + WS_HA); const bf16* MIX = (const bf16*)(a.ws + WS_HB);
    const bf16* p = PROJ + (size_t)m * NP;
    if (c < 128) lg[c] = 1.f / (1.f + expf(-(bf2f(p[C_PG + c]) + (t > 0 ? bf2f(p[C_QG + c - NP]) : 0.f))));
    else if (c < 192) la[c - 128] = bf2f(p[C_PA + c - 128]) + (t > 0 ? bf2f(p[C_QA + c - 128 - NP]) : 0.f);
    __syncthreads();
    float g = 0.f, ap = a.in[I_A0][l * RW + c];
    for (int j = 0; j < 128; ++j) g += lg[j] * a.in[I_G2][((size_t)l * 128 + j) * RW + c];
    for (int j = 0; j < 64; ++j) ap += la[j] * a.in[I_A2][((size_t)l * 64 + j) * RW + c];
    const float av = 1.f / (1.f + expf(-ap));
    const float mur = a.in[I_MURKV][l * 3 * RW + c], muk = a.in[I_MURKV][l * 3 * RW + RW + c], muv = a.in[I_MURKV][l * 3 * RW + 2 * RW + c];
    float r = bf2f(p[C_R + c]), k = bf2f(p[C_K + c]), v = bf2f(p[C_V + c]);
    if (t > 0) { r += (bf2f(p[C_R + c - NP]) - r) * mur; k += (bf2f(p[C_K + c - NP]) - k) * muk; v += (bf2f(p[C_V + c - NP]) - v) * muv; }
    else { r -= r * mur; k -= k * muk; v -= v * muv; }
    const float kp = k * (1.f + (av - 1.f) * a.in[I_KA][l * RW + c]);
    const float bon = wave_sum(r * kp * a.in[I_RK][l * RW + c]);
    const float y = bf2f(Y[(size_t)m * RW + c]);
    const float mean = wave_sum(y) * (1.f / 64.f), dd = y - mean, var = wave_sum(dd * dd) * (1.f / 64.f);
    const float ref = (dd * rsqrtf(var + GN_EPS) * a.in[I_LNXG][l * RW + c] + a.in[I_LNXB][l * RW + c] + bon * v) * g;
    const float got = bf2f(MIX[(size_t)m * DM + c]);
    diag_acc(a.ws, 3, (ref - got) * (ref - got), ref * ref);
    float n4 = 0.f, d4 = 0.f, n5 = 0.f, d5 = 0.f, cv = 0.f;
    if (c < 256) {
        float acc = 0.f;
        for (int kk = 0; kk < 3; ++kk) { const int tt = t - 2 + kk; if (tt >= 0) { const bf16* q = p - (size_t)(2 - kk) * NP; acc += a.in[I_SCW][(l * 3 + kk) * 256 + c] * bf2f(q[C_SCC + c]) * bf2f(q[C_SCU + c]); } }
        const float rs = bf2f(p[C_SCB + c]) * acc, gs = bf2f(MIX[(size_t)m * DM + 512 + c]);
        n4 = (rs - gs) * (rs - gs); d4 = rs * rs;
        cv = a.in[I_CFB][l * 256 + c];
        for (int kk = 0; kk < 31; ++kk) { const int tt = t - 30 + kk; if (tt >= 0) { const bf16* q = p - (size_t)(30 - kk) * NP; cv += a.in[I_CFW][((size_t)l * 31 + kk) * 256 + c] * bf2f(q[C_CFV + c]) / (1.f + expf(-bf2f(q[C_CFG + c]))); } }
    }
    diag_acc(a.ws, 4, n4, d4);
    float s = wave_sum(c < 256 ? cv : 0.f);
    if (lane == 0) red[wv] = s;
    __syncthreads();
    const float mean5 = (red[0] + red[1] + red[2] + red[3]) * (1.f / 256.f);
    const float dv = cv - mean5; s = wave_sum(c < 256 ? dv * dv : 0.f);
    if (lane == 0) red[8 + wv] = s;
    __syncthreads();
    const float var5 = (red[8] + red[9] + red[10] + red[11]) * (1.f / 256.f);
    if (c < 256) { float yy = dv * rsqrtf(var5 + LN_EPS) * a.in[I_CFLG][l * 256 + c] + a.in[I_CFLB][l * 256 + c]; yy = yy / (1.f + expf(-yy));
        const float gc = bf2f(MIX[(size_t)m * DM + 768 + c]); n5 = (yy - gc) * (yy - gc); d5 = yy * yy; }
    diag_acc(a.ws, 5, n5, d5);
}
__global__ void __launch_bounds__(512) diag_gemm_f32(Args a, size_t a_off, int K, int w_idx, size_t w_eloff, size_t tmp_off, int id) {
    __shared__ float arow[FF];
    const bf16* A = (const bf16*)(a.ws + a_off); const float* W = a.in[w_idx] + w_eloff; const float* TMP = (const float*)(a.ws + tmp_off);
    const int m = blockIdx.x * 257 + 7, tid = threadIdx.x;
    for (int k = tid; k < K; k += 512) arow[k] = bf2f(A[(size_t)m * K + k]);
    __syncthreads();
    float n = 0.f, d = 0.f;
    for (int c = tid; c < DM; c += 512) { float ref = 0.f; for (int k = 0; k < K; ++k) ref += arow[k] * W[(size_t)k * DM + c];
        const float e = ref - TMP[(size_t)m * DM + c]; n += e * e; d += ref * ref; }
    diag_acc(a.ws, id, n, d);
}
__global__ void __launch_bounds__(512) diag_norm(Args a, size_t tmp_off, int l, int id) {
    __shared__ float red[16];
    const float* TMP = (const float*)(a.ws + tmp_off); const float* xold = a.in[I_X]; const float* g1 = a.in[I_POSTMIX] + l * DM; const float* g2 = a.in[I_PREFFN] + l * DM;
    const int m = blockIdx.x * 257 + 7, tid = threadIdx.x, lane = tid & 63, wv = tid >> 6;
    const bf16* HA = (const bf16*)(a.ws + WS_HA);
    const float t0 = TMP[(size_t)m * DM + tid], t1 = TMP[(size_t)m * DM + 512 + tid];
    float s = wave_sum(t0 * t0 + t1 * t1); if (lane == 0) red[wv] = s; __syncthreads();
    float tot = 0.f; for (int i = 0; i < 8; ++i) tot += red[i];
    const float r = rsqrtf(tot * (1.f / DM) + NORM_EPS);
    const float x0 = xold[(size_t)m * DM + tid] + t0 * r * g1[tid], x1 = xold[(size_t)m * DM + 512 + tid] + t1 * r * g1[512 + tid];
    const float e0 = x0 - a.out[(size_t)m * DM + tid], e1 = x1 - a.out[(size_t)m * DM + 512 + tid];
    diag_acc(a.ws, id, e0 * e0 + e1 * e1, x0 * x0 + x1 * x1);
    s = wave_sum(x0 * x0 + x1 * x1); if (lane == 0) red[8 + wv] = s; __syncthreads();
    tot = 0.f; for (int i = 0; i < 8; ++i) tot += red[8 + i];
    const float r2 = rsqrtf(tot * (1.f / DM) + NORM_EPS);
    const float h0 = x0 * r2 * g2[tid], h1 = x1 * r2 * g2[512 + tid];
    const float f0 = h0 - bf2f(HA[(size_t)m * DM + tid]), f1 = h1 - bf2f(HA[(size_t)m * DM + 512 + tid]);
    diag_acc(a.ws, id + 1, f0 * f0 + f1 * f1, h0 * h0 + h1 * h1);
}
__global__ void __launch_bounds__(512) diag_swiglu(Args a, int l) {
    __shared__ float hrow[DM];
    const int m = blockIdx.x * 257 + 11, tid = threadIdx.x;
    const bf16* HA = (const bf16*)(a.ws + WS_HA); const bf16* Fb = (const bf16*)(a.ws + WS_PROJ);
    for (int k = tid; k < DM; k += 512) hrow[k] = bf2f(HA[(size_t)m * DM + k]);
    __syncthreads();
    float n = 0.f, d = 0.f;
    for (int c = tid; c < FF; c += 512) { float gg = 0.f, uu = 0.f; const float* Wg = a.in[I_WGATE] + (size_t)l * DM * FF + c; const float* Wu = a.in[I_WUP] + (size_t)l * DM * FF + c;
        for (int k = 0; k < DM; ++k) { gg += hrow[k] * Wg[(size_t)k * FF]; uu += hrow[k] * Wu[(size_t)k * FF]; }
        const float ref = gg / (1.f + expf(-gg)) * uu, e = ref - bf2f(Fb[(size_t)m * FF + c]); n += e * e; d += ref * ref; }
    diag_acc(a.ws, 11, n, d);
}
constexpr int DIAG_NID = 18;
__global__ void __launch_bounds__(256) diag_encode(Args a) {
    const float* D = (const float*)(a.ws + WS_CTL + 32768);
    int idx = 15; float dsel = 0.f;
    for (int q = 0; q < DIAG_NID; ++q) { const float d = D[2 * q] / fmaxf(D[2 * q + 1], 1e-30f); if (d > dsel) dsel = d; }
    for (int qq = 0; qq < DIAG_NID; ++qq) { const int q = qq < 6 ? 12 + qq : qq - 6; const float d = D[2 * q] / fmaxf(D[2 * q + 1], 1e-30f); if (!(d < 1e-3f)) { idx = qq; dsel = d; break; } }
    const float c = 3000.f * sqrtf(dsel);
    for (size_t i = (size_t)blockIdx.x * 256 + threadIdx.x; i < (size_t)M * DM; i += (size_t)gridDim.x * 256) a.out[i] = c;
    if (blockIdx.x == 0 && threadIdx.x == 0) a.out[0] = c * powf(1.6f, (float)(idx + 6));
}
#endif
#ifndef PH_MASK
#define PH_MASK 0x3ff
#endif
#define PH_ON(k) (((PH_MASK) >> (k)) & 1)
constexpr int PH_PER_LAYER = 10, N_PHASES = NL * PH_PER_LAYER;
__global__ void __launch_bounds__(NTHR, 2) fwd(Args args) {
    extern __shared__ __attribute__((aligned(16))) unsigned char lds_raw[];
    Frame F;
    F.lds = (LAS unsigned char*)lds_raw;
    F.tid = threadIdx.x; F.lane = F.tid & 63; F.wave = __builtin_amdgcn_readfirstlane(F.tid >> 6);
    F.blk = blockIdx.x; F.G = gridDim.x; F.in = args.in; F.out = args.out; F.ws = args.ws;
    volatile LAS unsigned* MISC = (volatile LAS unsigned*)(F.lds + MISC_OFF);
    if (F.tid < 32) MISC[F.tid] = 0u;
    __syncthreads();
    XcdBarrier bar; bar.bar = (unsigned*)(F.ws + WS_CTL) + 4096; bar.x = 0; bar.st = nullptr;
    const bool multi = (args.ph_hi - args.ph_lo) > 1;
    if (multi) bar = xcd_barrier_post((unsigned*)(F.ws + WS_CTL) + 4096, MISC + 8);
    bf16* WIN = (bf16*)(F.ws + WS_WIN); bf16* WO = (bf16*)(F.ws + WS_WO); bf16* WGU = (bf16*)(F.ws + WS_WGU); bf16* WDN = (bf16*)(F.ws + WS_WDN);
    bf16* HA = (bf16*)(F.ws + WS_HA); bf16* HB = (bf16*)(F.ws + WS_HB); bf16* PROJ = (bf16*)(F.ws + WS_PROJ);
    float* TMP1 = (float*)(F.ws + WS_PROJ); float* TMP2 = (float*)(F.ws + WS_X1);
    for (int ph = args.ph_lo; ph < args.ph_hi; ++ph) {
        const int l = ph / PH_PER_LAYER, k = ph % PH_PER_LAYER;
        { int t_ = threadIdx.x; asm volatile("" : "+v"(t_)); F.tid = t_; F.lane = t_ & 63; F.wave = __builtin_amdgcn_readfirstlane(t_ >> 6); }
        switch (k) {
        case 0: if (PH_ON(0)) { phase_conv(F, l); if (l == 0) phase_norm0(F); } break;
        case 1: if (PH_ON(1)) { pg8::Gemm g{HA, WIN, M, NP, DM}; pg8::StaticOrder S; S.init(M, NP, F.G, F.blk); pg8::EpiBf16 E{PROJ, NP};
                  pg8::gemm_phase<pg8::EpiBf16, pg8::StaticOrder, true, true>(F.lds, g, S, E); } break;
        case 2: if (PH_ON(2)) phase_prep(F, l); break;
        case 3: if (PH_ON(3)) phase_scan(F, l); break;
        case 4: if (PH_ON(4)) { phase_post(F, l); phase_sc(F, l); phase_cf(F, l); } break;
        case 5: if (PH_ON(5)) { pg8::Gemm g{HB, WO, M, DM, DM}; pg8::StaticOrder S; S.init(M, DM, F.G, F.blk); pg8::EpiF32 E{TMP1, DM};
                  pg8::gemm_phase<pg8::EpiF32, pg8::StaticOrder, true, true>(F.lds, g, S, E); } break;
        case 6: if (PH_ON(6)) phase_norm_res(F, TMP1, l == 0 ? F.in[I_X] : F.out, F.in[I_POSTMIX] + l * DM, F.in[I_PREFFN] + l * DM); break;
        case 7: if (PH_ON(7)) { pg8::Gemm g{HA, WGU, M, NGU, DM}; pg8::StaticOrder S; S.init(M, NGU, F.G, F.blk); pg8::EpiSwiGLU E{PROJ, FF};
                  pg8::gemm_phase<pg8::EpiSwiGLU, pg8::StaticOrder, true, true>(F.lds, g, S, E); } break;
        case 8: if (PH_ON(8)) { pg8::Gemm g{PROJ, WDN, M, DM, FF}; pg8::StaticOrder S; S.init(M, DM, F.G, F.blk); pg8::EpiF32 E{TMP2, DM};
                  pg8::gemm_phase<pg8::EpiF32, pg8::StaticOrder, true, true>(F.lds, g, S, E); } break;
        case 9: if (PH_ON(9)) phase_norm_res(F, TMP2, F.out, F.in[I_POSTFFN] + l * DM, l + 1 < NL ? F.in[I_PREMIX] + (l + 1) * DM : nullptr); break;
        }
        if (ph + 1 < args.ph_hi) xcd_barrier(bar);
    }
}

#ifndef MK_ONE_LAUNCH
#define MK_ONE_LAUNCH 1
#endif
extern "C" void kernel_launch(void* const* d_in, const int* in_sizes, int n_in, void* d_out, int out_size, void* d_ws, size_t ws_size, hipStream_t stream) {
    static int grid = 0;
    if (grid == 0) {
        if (n_in != N_IN || in_sizes[0] != M * DM || out_size != M * DM || ws_size < WS_END) { fprintf(stderr, "kernel_launch: unexpected shapes (n_in %d, ws %zu)\n", n_in, ws_size); grid = -1; return; }
        int dev = 0, cus = 0, per_cu = 0;
        if (hipGetDevice(&dev) != hipSuccess || hipDeviceGetAttribute(&cus, hipDeviceAttributeMultiprocessorCount, dev) != hipSuccess) { grid = -1; return; }
        if (hipFuncSetAttribute((const void*)fwd, hipFuncAttributeMaxDynamicSharedMemorySize, LDS_BYTES) != hipSuccess) { fprintf(stderr, "kernel_launch: hipFuncSetAttribute failed\n"); grid = -1; return; }
        if (hipOccupancyMaxActiveBlocksPerMultiprocessor(&per_cu, (const void*)fwd, NTHR, LDS_BYTES) != hipSuccess || per_cu < 1) { fprintf(stderr, "kernel_launch: occupancy query says %d blocks per CU\n", per_cu); grid = -1; (void)hipGetLastError(); return; }
        grid = cus;
    }
    if (grid < 0) return;
    (void)hipMemsetAsync((char*)d_ws + WS_CTL, 0, CTL_ZERO_BYTES, stream);
    Args a{};
    for (int i = 0; i < N_IN; ++i) a.in[i] = (const float*)d_in[i];
    a.out = (float*)d_out; a.ws = (unsigned char*)d_ws;
#if MK_ONE_LAUNCH
    a.ph_lo = 0; a.ph_hi = N_PHASES;
    hipLaunchKernelGGL(fwd, dim3(grid), dim3(NTHR), LDS_BYTES, stream, a);
#else
    for (int ph = 0; ph < N_PHASES; ++ph) { a.ph_lo = ph; a.ph_hi = ph + 1; hipLaunchKernelGGL(fwd, dim3(grid), dim3(NTHR), LDS_BYTES, stream, a);
#if DIAG
        const int l = ph / PH_PER_LAYER, k = ph % PH_PER_LAYER;
        if (l == DIAG_L) {
            if (k == 1) hipLaunchKernelGGL(diag_proj, dim3(64), dim3(512), 0, stream, a, l);
            if (k == 3) hipLaunchKernelGGL(diag_y, dim3(8), dim3(64), 0, stream, a, l);
            if (k == 4) hipLaunchKernelGGL(diag_mix, dim3(63), dim3(512), 0, stream, a, l);
            if (k == 5) hipLaunchKernelGGL(diag_gemm_f32, dim3(63), dim3(512), 0, stream, a, (size_t)WS_HB, (int)DM, (int)I_WO, (size_t)l * DM * DM, (size_t)WS_PROJ, 6);
            if (k == 6 && l == 0) hipLaunchKernelGGL(diag_norm, dim3(63), dim3(512), 0, stream, a, (size_t)WS_PROJ, l, 7);
            if (k == 7) hipLaunchKernelGGL(diag_swiglu, dim3(63), dim3(512), 0, stream, a, l);
            if (k == 8) hipLaunchKernelGGL(diag_gemm_f32, dim3(63), dim3(512), 0, stream, a, (size_t)WS_PROJ, (int)FF, (int)I_WDOWN, (size_t)l * FF * DM, (size_t)WS_X1, 9);
        }
#endif
    }
#if DIAG
    hipLaunchKernelGGL(diag_encode, dim3(1024), dim3(256), 0, stream, a);
#endif
#endif
}
```

```cpp
#include <hip/hip_runtime.h>
#include <cstdio>
#include <cstdint>
#ifndef DIAG
#define DIAG 0
#endif
namespace pg8 {
#define PG8_LAS __attribute__((address_space(3)))
typedef unsigned short bf16_t;
typedef short bf16x8 __attribute__((ext_vector_type(8)));
typedef float f32x4 __attribute__((ext_vector_type(4)));
typedef unsigned u32x4 __attribute__((ext_vector_type(4)));
constexpr int BM = 256, BK = 64, HALF = 128, HTB = HALF * BK * 2  , STAGE_BYTES = 8 * HTB, NXCD = 8, WGM = 8;

__host__ __device__ __forceinline__ int lds_byte(int r, int c) { const int st = (r >> 4) * 2 + (c >> 5), rr = r & 15, cc = c & 31, ob = rr * 64 + cc * 2; return st * 1024 + (ob ^ (((ob >> 9) & 1) << 5)); }
__host__ __device__ __forceinline__ void stage_rc(int b, int& R, int& C) { const int st = b / 1024, sb = b % 1024, swz = sb ^ (((sb >> 9) & 1) << 5); R = (st >> 1) * 16 + swz / 64; C = (st & 1) * 32 + (swz % 64) / 2; }
__host__ __device__ __forceinline__ int perm32(int rho) { const int n = rho >> 4, i = rho & 15; return 8 * (i >> 2) + 4 * n + (i & 3); }

struct Unit { int pm, pn; };
struct Gemm { const bf16_t* A; const bf16_t* Bt; int M, N, K; };

struct StaticOrder {
    int nM, nN, nwg, G, c;
    __host__ __device__ void init(int M, int N, int G_, int c_) { nM = M / BM; nN = N / BM; nwg = nM * nN; G = G_; c = c_; }
    __host__ __device__ bool next(int i, Unit& u) const {
        const long L = (long)i * G + c; if (L >= nwg) return false;
        int wgid = (int)L; { const int q = nwg / NXCD, r = nwg % NXCD, xcd = wgid % NXCD, off = wgid / NXCD; wgid = (xcd < r ? xcd * (q + 1) : r * (q + 1) + (xcd - r) * q) + off; }
        const int nig = WGM * nN, gid = wgid / nig, fm = gid * WGM, gsz = (nM - fm) < WGM ? (nM - fm) : WGM;
        u.pm = fm + ((wgid % nig) % gsz); u.pn = (wgid % nig) / gsz; return true;
    }
    __device__ __forceinline__ void a_ready(const Unit&) const {}
    __device__ __forceinline__ void done(const Unit&) const {}
};

__device__ __forceinline__ unsigned cvt_pk_bf16(float lo, float hi) { unsigned r; asm volatile("v_cvt_pk_bf16_f32 %0, %1, %2" : "=v"(r) : "v"(lo), "v"(hi)); return r; }
typedef float f32x2 __attribute__((ext_vector_type(2)));
struct EpiBf16 {
    static constexpr bool PERM = true, AFTER_DRAIN = false;
    bf16_t* O; int ldc;
    __device__ __forceinline__ void operator()(const f32x4 (&acc)[2][2][4][2], const Unit& u, int wr, int wc, int fr, int fq) const {
        const int row0 = u.pm * BM + wr * 64 + fr, col0 = u.pn * BM + wc * 32 + 8 * fq;
#pragma unroll
        for (int ai = 0; ai < 2; ++ai)
#pragma unroll
            for (int m = 0; m < 4; ++m) { bf16_t* rowp = O + (size_t)(row0 + ai * HALF + m * 16) * ldc + col0;
#pragma unroll
                for (int bj = 0; bj < 2; ++bj) { const f32x4 v0 = acc[ai][bj][m][0], v1 = acc[ai][bj][m][1];
                    u32x4 w; w.x = cvt_pk_bf16(v0[0], v0[1]); w.y = cvt_pk_bf16(v0[2], v0[3]); w.z = cvt_pk_bf16(v1[0], v1[1]); w.w = cvt_pk_bf16(v1[2], v1[3]);
                    *(u32x4*)(rowp + bj * HALF) = w; } }
    }
};
struct EpiF32 {
    static constexpr bool PERM = false, AFTER_DRAIN = false;
    float* C; int ldc;
    __device__ __forceinline__ void operator()(const f32x4 (&acc)[2][2][4][2], const Unit& u, int wr, int wc, int fr, int fq) const {
        const int row0 = u.pm * BM + wr * 64 + fr, col0 = u.pn * BM + wc * 32 + 4 * fq;
#pragma unroll
        for (int ai = 0; ai < 2; ++ai)
#pragma unroll
            for (int m = 0; m < 4; ++m) { float* rowp = C + (size_t)(row0 + ai * HALF + m * 16) * ldc + col0;
#pragma unroll
                for (int bj = 0; bj < 2; ++bj)
#pragma unroll
                    for (int n = 0; n < 2; ++n) *(f32x4*)(rowp + bj * HALF + n * 16) = acc[ai][bj][m][n]; }
    }
};
struct EpiSwiGLU {
    static constexpr bool PERM = true, AFTER_DRAIN = false;
    bf16_t* O; int ldc;
    __device__ __forceinline__ void operator()(const f32x4 (&acc)[2][2][4][2], const Unit& u, int wr, int wc, int fr, int fq) const {
        const int row0 = u.pm * BM + wr * 64 + fr, col0 = u.pn * HALF + wc * 32 + 8 * fq;
#pragma unroll
        for (int ai = 0; ai < 2; ++ai)
#pragma unroll
            for (int m = 0; m < 4; ++m) { bf16_t* rowp = O + (size_t)(row0 + ai * HALF + m * 16) * ldc + col0;
                float o[8];
#pragma unroll
                for (int n = 0; n < 2; ++n)
#pragma unroll
                    for (int e = 0; e < 4; ++e) { const float g = acc[ai][0][m][n][e], up = acc[ai][1][m][n][e];
                        o[n * 4 + e] = g * __builtin_amdgcn_rcpf(1.0f + __builtin_amdgcn_exp2f(-1.44269504089f * g)) * up; }
                u32x4 w; w.x = cvt_pk_bf16(o[0], o[1]); w.y = cvt_pk_bf16(o[2], o[3]); w.z = cvt_pk_bf16(o[4], o[5]); w.w = cvt_pk_bf16(o[6], o[7]);
                *(u32x4*)rowp = w; }
    }
};

template <class Epi, class Sched, bool ALIGN_EPI = false, bool SP2 = false>
__device__ __forceinline__ void gemm_phase(PG8_LAS unsigned char* lds, const Gemm g, const Sched& S, const Epi& E) {
    int tid_l = threadIdx.x; asm volatile("" : "+v"(tid_l));
    const int tid = tid_l, wid = __builtin_amdgcn_readfirstlane(tid >> 6), lane = tid & 63, wr = wid >> 2, wc = wid & 3, fr = lane & 15, fq = lane >> 4;
    const int K = g.K, nt = K / BK;
    unsigned voffA[2], voffB[2];
#pragma unroll
    for (int i = 0; i < 2; ++i) { int R, C; stage_rc(tid * 16 + i * 8192, R, C); const int Rb = Epi::PERM ? ((R & ~31) + perm32(R & 31)) : R;
        voffA[i] = (unsigned)(R * K + C) * 2u; voffB[i] = (unsigned)(Rb * K + C) * 2u; }
    const size_t kstep = (size_t)(BK * 2);
    const size_t hstep = (size_t)HALF * K * 2;
    const size_t tstep = 2 * hstep;
    const unsigned ldsw = (unsigned)wid * 1024u;
    const int aoff = lds_byte(wr * 64 + fr, fq * 8), boff = lds_byte(wc * 32 + fr, fq * 8);
#define PG8_SA(b, h) (((b) * 2 + (h)) * HTB)
#define PG8_SB(b, h) ((4 + (b) * 2 + (h)) * HTB)
#define PG8_STAGE(bufoff, gbase, voff) do { _Pragma("unroll") for (int _i = 0; _i < 2; ++_i) \
        __builtin_amdgcn_global_load_lds((const unsigned*)((const char*)(gbase) + (voff)[_i]), (PG8_LAS unsigned*)(lds + (bufoff) + ldsw + _i * 8192), 16, 0, 0); } while (0)
#define PG8_LDA(dst, b, h) do { _Pragma("unroll") for (int m = 0; m < 4; ++m) _Pragma("unroll") for (int k = 0; k < 2; ++k) dst[m][k] = *(const PG8_LAS bf16x8*)(lds + PG8_SA(b, h) + aoff + m * 2048 + k * 1024); } while (0)
#define PG8_LDB(dst, b, h) do { _Pragma("unroll") for (int n = 0; n < 2; ++n) _Pragma("unroll") for (int k = 0; k < 2; ++k) dst[n][k] = *(const PG8_LAS bf16x8*)(lds + PG8_SB(b, h) + boff + n * 2048 + k * 1024); } while (0)
#define PG8_MMA(ai, bj, At, Bt) do { __builtin_amdgcn_s_setprio(1); _Pragma("unroll") for (int m = 0; m < 4; ++m) _Pragma("unroll") for (int n = 0; n < 2; ++n) _Pragma("unroll") for (int k = 0; k < 2; ++k) \
        acc[ai][bj][m][n] = __builtin_amdgcn_mfma_f32_16x16x32_bf16(Bt[n][k], At[m][k], acc[ai][bj][m][n], 0, 0, 0); __builtin_amdgcn_s_setprio(0); } while (0)
#define PG8_WAIT_V(n) asm volatile("s_waitcnt vmcnt(" #n ")" ::: "memory")
#define PG8_WAIT_L(n) asm volatile("s_waitcnt lgkmcnt(" #n ")" ::: "memory")
#define PG8_BAR __builtin_amdgcn_s_barrier()
#define PG8_SCHED __builtin_amdgcn_sched_barrier(0)
    Unit cur, nxt; int ui = 0;
    if (!S.next(0, cur)) return;
    f32x4 acc[2][2][4][2];
#pragma unroll
    for (int a = 0; a < 2; ++a)
#pragma unroll
        for (int b = 0; b < 2; ++b)
#pragma unroll
            for (int m = 0; m < 4; ++m)
#pragma unroll
                for (int n = 0; n < 2; ++n) acc[a][b][m][n] = (f32x4){0.f, 0.f, 0.f, 0.f};
    bf16x8 At[4][2], B0[2][2], B1[2][2];
    const char* cA = (const char*)g.A + (size_t)cur.pm * tstep; const char* cB = (const char*)g.Bt + (size_t)cur.pn * tstep;
    S.a_ready(cur);
    if constexpr (SP2) {
        PG8_STAGE(PG8_SB(0, 0), cB, voffB); PG8_STAGE(PG8_SB(0, 1), cB + hstep, voffB); PG8_STAGE(PG8_SA(0, 0), cA, voffA); PG8_STAGE(PG8_SA(0, 1), cA + hstep, voffA);
        if (wr == 1) PG8_BAR;
        PG8_WAIT_V(2); PG8_BAR;
        PG8_STAGE(PG8_SB(1, 0), cB + kstep, voffB); PG8_STAGE(PG8_SA(1, 0), cA + kstep, voffA); PG8_STAGE(PG8_SB(1, 1), cB + hstep + kstep, voffB);
        PG8_WAIT_V(6); PG8_BAR;
    } else {
        PG8_STAGE(PG8_SB(0, 0), cB, voffB); PG8_STAGE(PG8_SA(0, 0), cA, voffA); PG8_STAGE(PG8_SB(0, 1), cB + hstep, voffB); PG8_STAGE(PG8_SA(0, 1), cA + hstep, voffA);
        if (wr == 1) PG8_BAR;
        PG8_WAIT_V(4); PG8_BAR;
        PG8_STAGE(PG8_SB(1, 0), cB + kstep, voffB); PG8_STAGE(PG8_SA(1, 0), cA + kstep, voffA); PG8_STAGE(PG8_SB(1, 1), cB + hstep + kstep, voffB);
        PG8_WAIT_V(6); PG8_BAR;
    }
    for (;;) {
        const bool has_next = S.next(ui + 1, nxt);
        const char* nA = has_next ? (const char*)g.A + (size_t)nxt.pm * tstep : cA; const char* nB = has_next ? (const char*)g.Bt + (size_t)nxt.pn * tstep : cB;
        for (int t = 0; t < nt; t += 2) {
            const bool last = (t == nt - 2);
            const char* a1 = cA + (size_t)(t + 1) * kstep;
            const char* a2 = last ? nA : cA + (size_t)(t + 2) * kstep; const char* b2 = last ? nB : cB + (size_t)(t + 2) * kstep;
            const char* a3 = a2 + kstep; const char* b3 = b2 + kstep;
            if (last && has_next) S.a_ready(nxt);
            if constexpr (SP2) {
            PG8_LDB(B0, 0, 0); PG8_LDB(B1, 0, 1); PG8_SCHED; PG8_LDA(At, 0, 0); PG8_STAGE(PG8_SA(1, 1), a1 + hstep, voffA);
            PG8_WAIT_V(8); PG8_WAIT_L(0); PG8_BAR; PG8_MMA(0, 0, At, B0); PG8_MMA(0, 1, At, B1); PG8_BAR; PG8_SCHED;
            PG8_LDA(At, 0, 1); PG8_STAGE(PG8_SB(0, 0), b2, voffB); PG8_STAGE(PG8_SB(0, 1), b2 + hstep, voffB); PG8_STAGE(PG8_SA(0, 0), a2, voffA);
            PG8_WAIT_V(8); PG8_WAIT_L(0); PG8_BAR; PG8_MMA(1, 0, At, B0); PG8_MMA(1, 1, At, B1); PG8_BAR; PG8_SCHED;
            PG8_LDB(B0, 1, 0); PG8_LDB(B1, 1, 1); PG8_SCHED; PG8_LDA(At, 1, 0); PG8_STAGE(PG8_SA(0, 1), a2 + hstep, voffA);
            PG8_WAIT_V(8); PG8_WAIT_L(0); PG8_BAR; PG8_MMA(0, 0, At, B0); PG8_MMA(0, 1, At, B1); PG8_BAR; PG8_SCHED;
            PG8_LDA(At, 1, 1); PG8_STAGE(PG8_SB(1, 0), b3, voffB); PG8_STAGE(PG8_SB(1, 1), b3 + hstep, voffB); PG8_STAGE(PG8_SA(1, 0), a3, voffA);
            PG8_WAIT_V(8); PG8_WAIT_L(0); PG8_BAR; PG8_MMA(1, 0, At, B0); PG8_MMA(1, 1, At, B1); PG8_BAR; PG8_SCHED;
            } else {
            PG8_LDB(B0, 0, 0); PG8_SCHED; PG8_LDA(At, 0, 0); PG8_STAGE(PG8_SA(1, 1), a1 + hstep, voffA);
            PG8_WAIT_L(8); PG8_BAR; PG8_WAIT_L(0); PG8_MMA(0, 0, At, B0); PG8_BAR; PG8_SCHED;
            PG8_LDB(B1, 0, 1); PG8_STAGE(PG8_SB(0, 0), b2, voffB);
            PG8_BAR; PG8_WAIT_L(0); PG8_MMA(0, 1, At, B1); PG8_BAR;
            PG8_LDA(At, 0, 1); PG8_STAGE(PG8_SA(0, 0), a2, voffA);
            PG8_BAR; PG8_WAIT_L(0); PG8_MMA(1, 0, At, B0); PG8_BAR; PG8_SCHED;
            PG8_STAGE(PG8_SB(0, 1), b2 + hstep, voffB);
            PG8_WAIT_V(6); PG8_BAR; PG8_MMA(1, 1, At, B1); PG8_BAR;
            PG8_LDB(B0, 1, 0); PG8_SCHED; PG8_LDA(At, 1, 0); PG8_STAGE(PG8_SA(0, 1), a2 + hstep, voffA);
            PG8_WAIT_L(8); PG8_BAR; PG8_WAIT_L(0); PG8_MMA(0, 0, At, B0); PG8_BAR; PG8_SCHED;
            PG8_LDB(B1, 1, 1); PG8_STAGE(PG8_SB(1, 0), b3, voffB);
            PG8_BAR; PG8_WAIT_L(0); PG8_MMA(0, 1, At, B1); PG8_BAR;
            PG8_LDA(At, 1, 1); PG8_STAGE(PG8_SA(1, 0), a3, voffA);
            PG8_BAR; PG8_WAIT_L(0); PG8_MMA(1, 0, At, B0); PG8_BAR; PG8_SCHED;
            PG8_STAGE(PG8_SB(1, 1), b3 + hstep, voffB);
            PG8_WAIT_V(6); PG8_BAR; PG8_MMA(1, 1, At, B1); PG8_BAR;
            }
        }
        if constexpr (ALIGN_EPI) { if (wr == 0) PG8_BAR; }
        if constexpr (!Epi::AFTER_DRAIN) { E(acc, cur, wr, wc, fr, fq); S.done(cur); }
        if (!has_next) break;
#pragma unroll
        for (int a = 0; a < 2; ++a)
#pragma unroll
            for (int b = 0; b < 2; ++b)
#pragma unroll
                for (int m = 0; m < 4; ++m)
#pragma unroll
                    for (int n = 0; n < 2; ++n) acc[a][b][m][n] = (f32x4){0.f, 0.f, 0.f, 0.f};
        cur = nxt; cA = nA; cB = nB; ++ui;
        if constexpr (ALIGN_EPI) { if (wr == 1) PG8_BAR; }
    }
    PG8_WAIT_V(0);
    if constexpr (!ALIGN_EPI) { if (wr == 0) PG8_BAR; }
    PG8_BAR;
    if constexpr (Epi::AFTER_DRAIN) { E.fused(acc, cur, wr, wc, fr, fq, lds, wid, lane); S.done(cur); }
#undef PG8_SA
#undef PG8_SB
#undef PG8_STAGE
#undef PG8_LDA
#undef PG8_LDB
#undef PG8_MMA
#undef PG8_WAIT_V
#undef PG8_WAIT_L
#undef PG8_BAR
#undef PG8_SCHED
}
}

constexpr int NWAVES = 8, NTHR = 512;
constexpr int NB = 8, NT = 2048, DM = 1024, M = NB * NT, NL = 4;
constexpr int RW = 512, NH = 8, INW = 2816, NP = 3328, FF = 2816, NGU = 2 * FF;
constexpr int C_R = 0, C_K = 512, C_V = 1024, C_SCB = 1536, C_SCC = 1792, C_SCU = 2048, C_CFV = 2304, C_CFG = 2560;
constexpr int C_PW = 2816, C_PA = 2880, C_PG = 2944, C_QW = 3072, C_QA = 3136, C_QG = 3200;
constexpr float NORM_EPS = 1e-6f, LN_EPS = 1e-5f, GN_EPS = 64e-5f;

enum { I_X = 0, I_WIN, I_MURKV, I_MUWAG, I_W0, I_W1, I_W2, I_A0, I_A1, I_A2, I_G1, I_G2, I_KK, I_KA, I_RK, I_LNXG, I_LNXB, I_SCW, I_CFW, I_CFB, I_CFLG, I_CFLB,
       I_WO, I_WGATE, I_WUP, I_WDOWN, I_PREMIX, I_POSTMIX, I_PREFFN, I_POSTFFN, N_IN };

constexpr size_t MiB = 1u << 20;
constexpr size_t WS_CTL = 0, CTL_ZERO_BYTES = 64 * 1024;
constexpr size_t WS_WIN = 1 * MiB;
constexpr size_t WS_WO = WS_WIN + (size_t)NP * DM * 2;
constexpr size_t WS_WGU = WS_WO + (size_t)DM * DM * 2;
constexpr size_t WS_WDN = WS_WGU + (size_t)NGU * DM * 2;
constexpr size_t WS_HA = 27 * MiB;
constexpr size_t WS_HB = 59 * MiB;
constexpr size_t WS_PROJ = 91 * MiB;
constexpr size_t WS_X1 = 195 * MiB;
constexpr size_t WS_BON = 259 * MiB;
constexpr size_t WS_END = WS_BON + (size_t)M * 8 * 4;
static_assert(WS_WDN + (size_t)DM * FF * 2 <= WS_HA, "weights fit");
static_assert(WS_PROJ + (size_t)M * NP * 2 <= WS_X1, "proj fits");

#define GAS __attribute__((address_space(1)))
#define LAS __attribute__((address_space(3)))
typedef unsigned short bf16;
typedef unsigned v4u __attribute__((ext_vector_type(4)));
typedef unsigned v2u __attribute__((ext_vector_type(2)));
typedef float f32x4 __attribute__((ext_vector_type(4)));
typedef GAS unsigned gu32;
#define LDS_WAIT() asm volatile("s_waitcnt lgkmcnt(0)" ::: "memory")

__device__ __forceinline__ unsigned f2bf(float f) { unsigned u = __builtin_bit_cast(unsigned, f); return (u + 0x7fffu + ((u >> 16) & 1u)) >> 16; }
__device__ __forceinline__ unsigned pk2(float lo, float hi) { return f2bf(lo) | (f2bf(hi) << 16); }
__device__ __forceinline__ float bf2f(unsigned short u) { return __builtin_bit_cast(float, (unsigned)u << 16); }
__device__ __forceinline__ float bflo(unsigned u) { return __builtin_bit_cast(float, u << 16); }
__device__ __forceinline__ float bfhi(unsigned u) { return __builtin_bit_cast(float, u & 0xffff0000u); }
__device__ __forceinline__ float sigmoidf_(float x) { return 1.0f / (1.0f + __expf(-x)); }

__device__ __forceinline__ float wave_sum(float v) {
#pragma unroll
    for (int o = 1; o < 64; o <<= 1) v += __shfl_xor(v, o);
    return v;
}
template <int CTRL> __device__ __forceinline__ float dpp_mov(float x) { return __builtin_bit_cast(float, __builtin_amdgcn_update_dpp(0, __builtin_bit_cast(int, x), CTRL, 0xf, 0xf, true)); }
__device__ __forceinline__ float allreduce16(float x) {
    x += dpp_mov<0xB1>(x);
    x += dpp_mov<0x4E>(x);
    x += dpp_mov<0x141>(x);
    x += dpp_mov<0x140>(x);
    return x;
}

__device__ __forceinline__ float rdlane(float x, int lane) { return __builtin_bit_cast(float, __builtin_amdgcn_readlane(__builtin_bit_cast(int, x), lane)); }
__device__ __forceinline__ float wave_allsum(float x) {
    x = allreduce16(x);
    return (rdlane(x, 0) + rdlane(x, 16)) + (rdlane(x, 32) + rdlane(x, 48));
}
typedef short bf16x8 __attribute__((ext_vector_type(8)));
typedef float f32x16 __attribute__((ext_vector_type(16)));
#define MFMA32(a, b, c) __builtin_amdgcn_mfma_f32_32x32x16_bf16((a), (b), (c), 0, 0, 0)
__device__ __forceinline__ int crow(int reg, int hh) { return (reg & 3) + 8 * (reg >> 2) + 4 * hh; }
__device__ __forceinline__ float tanh_fast(float x) { return 1.0f - 2.0f * __builtin_amdgcn_rcpf(1.0f + __expf(2.0f * x)); }
__device__ __forceinline__ float sigm_fast(float x) { return __builtin_amdgcn_rcpf(1.0f + __expf(-x)); }

#define XB_TMO      128
#define XB_XCNT(j)  (256  + 64 * (j))
#define XB_XSUB(j)  (1280 + 64 * (j))
#define XB_XGEN(j)  (2304 + 64 * (j))
#define XB_TOP      3328
#define XB_TOPGEN   3392
#define XCD_BAR_WORDS 3456
#define XB_SPIN_CAP (1u << 18)
__device__ __forceinline__ unsigned xb_ld(unsigned* p)              { return __hip_atomic_load(p, __ATOMIC_RELAXED, __HIP_MEMORY_SCOPE_AGENT); }
__device__ __forceinline__ unsigned xb_add(unsigned* p, unsigned v) { return __hip_atomic_fetch_add(p, v, __ATOMIC_RELAXED, __HIP_MEMORY_SCOPE_AGENT); }
__device__ __forceinline__ unsigned xb_xcc_id() { return (unsigned)__builtin_amdgcn_s_getreg((3 << 11) | 20) & 0xFu; }
#define XB_SPIN(cond, bar) do { unsigned _sp = 0; while (cond) { __builtin_amdgcn_s_sleep(1); \
    if ((++_sp & 255u) == 0u) { if (xb_ld(&(bar)[XB_TMO])) break; if (_sp > XB_SPIN_CAP) { atomicAdd(&(bar)[XB_TMO], 1u); break; } } } } while (0)
struct XcdBarrier { unsigned* bar; unsigned x; volatile LAS unsigned* st; };
__device__ __forceinline__ XcdBarrier xcd_barrier_post(unsigned* bar, volatile LAS unsigned* st) {
    XcdBarrier b; b.bar = bar; b.x = xb_xcc_id(); b.st = st;
    if (threadIdx.x == 0) (void)xb_add(&bar[XB_XCNT(b.x)], 1u);
    return b;
}
__device__ __forceinline__ void xcd_barrier_complete(unsigned* bar, unsigned x, unsigned& nloc, unsigned& nx) {
    const unsigned G = gridDim.x * gridDim.y * gridDim.z;
    unsigned sum, cnt, mine, sp = 0u;
    for (;;) {
        sum = 0u; cnt = 0u; mine = 0u;
#pragma unroll
        for (unsigned j = 0; j < 16; ++j) { const unsigned c = xb_ld(&bar[XB_XCNT(j)]); sum += c; cnt += (c > 0u) ? 1u : 0u; mine = (j == x) ? c : mine; }
        if (sum == G) break;
        __builtin_amdgcn_s_sleep(1);
        if ((++sp & 255u) == 0u) { if (xb_ld(&bar[XB_TMO])) break; if (sp > XB_SPIN_CAP) { atomicAdd(&bar[XB_TMO], 1u); break; } }
    }
    nloc = mine > 0u ? mine : 1u; nx = cnt > 0u ? cnt : 1u;
}
__device__ __forceinline__ void xcd_barrier(const XcdBarrier& b) {
    asm volatile("s_waitcnt vmcnt(0)" ::: "memory");
    __syncthreads();
    if (threadIdx.x == 0) {
        unsigned* bar = b.bar;
        __builtin_amdgcn_s_waitcnt(0);
        unsigned nloc = b.st[0], nx = b.st[1];
        if (nloc == 0u) { xcd_barrier_complete(bar, b.x, nloc, nx); b.st[0] = nloc; b.st[1] = nx; }
        const unsigned old = xb_add(&bar[XB_XSUB(b.x)], 1u);
        const unsigned gen = old / nloc;
        if (old + 1u == (gen + 1u) * nloc) {
            __builtin_amdgcn_fence(__ATOMIC_RELEASE, "agent");
            asm volatile("s_waitcnt vmcnt(0)" ::: "memory");
            const unsigned og = xb_add(&bar[XB_TOP], 1u);
            const unsigned tg = og / nx;
            if (og + 1u == (tg + 1u) * nx) xb_add(&bar[XB_TOPGEN], 1u);
            else XB_SPIN(xb_ld(&bar[XB_TOPGEN]) == tg, bar);
            __builtin_amdgcn_fence(__ATOMIC_ACQUIRE, "agent");
            xb_add(&bar[XB_XGEN(b.x)], 1u);
            asm volatile("s_waitcnt vmcnt(0)" ::: "memory");
        } else {
            XB_SPIN(xb_ld(&bar[XB_XGEN(b.x)]) == gen, bar);
            __builtin_amdgcn_fence(__ATOMIC_ACQUIRE, "agent");
            asm volatile("s_waitcnt vmcnt(0)" ::: "memory");
        }
    }
    __syncthreads();
}

constexpr int RING_BYTES = 131072, MISC_OFF = RING_BYTES + 320, LDS_BYTES = 147456;

struct Args { const float* in[N_IN]; float* out; unsigned char* ws; int ph_lo, ph_hi; };

struct Frame {
    LAS unsigned char* lds;
    int tid, lane, wave, blk, G;
    const float* const* in; float* out; unsigned char* ws;
};

__device__ __forceinline__ void transpose_item(const float* W, int K, int N, bf16* WT, int dst_row0, int k0, int n0, const float* s, int mode, LAS float* scr, int lane) {
#pragma unroll 8
    for (int i = 0; i < 32; ++i) { const int kk = 2 * i + (lane >> 5); float v = W[(size_t)(k0 + kk) * N + n0 + (lane & 31)];
        if (mode) { const float sv = s[k0 + kk]; v *= (mode == 1) ? sv : (1.0f - sv); }
        scr[kk * 33 + (lane & 31)] = v; }
    LDS_WAIT(); asm volatile("" ::: "memory");
    const int c = lane & 7;
#pragma unroll
    for (int j = 0; j < 4; ++j) { const int n = (lane >> 3) + 8 * j; const LAS float* p = scr + (8 * c) * 33 + n;
        v4u o; o.x = pk2(p[0 * 33], p[1 * 33]); o.y = pk2(p[2 * 33], p[3 * 33]); o.z = pk2(p[4 * 33], p[5 * 33]); o.w = pk2(p[6 * 33], p[7 * 33]);
        *(GAS v4u*)(WT + (size_t)(dst_row0 + n) * K + k0 + 8 * c) = o; }
    LDS_WAIT(); asm volatile("" ::: "memory");
}
__device__ __forceinline__ void phase_conv(const Frame& F, int l) {
    LAS float* scr = (LAS float*)(F.lds + F.wave * 16384);
    const int gw = F.blk * NWAVES + F.wave, NGW = F.G * NWAVES;
    bf16* WIN = (bf16*)(F.ws + WS_WIN); bf16* WO = (bf16*)(F.ws + WS_WO); bf16* WGU = (bf16*)(F.ws + WS_WGU); bf16* WDN = (bf16*)(F.ws + WS_WDN);
    constexpr int I_IN = 16 * 88, I_LORA = 256, I_O = 16 * 32, I_G = 16 * 88, I_D = 44 * 32;
    constexpr int NITEMS = I_IN + I_LORA + I_O + 2 * I_G + I_D;
    const float* mu = F.in[I_MUWAG] + (size_t)l * 3 * DM;
    for (int it = gw; it < NITEMS; it += NGW) {
        int r = it;
        if (r < I_IN) { const int kb = r / 88, nb = r % 88; transpose_item(F.in[I_WIN] + (size_t)l * DM * INW, DM, INW, WIN, 32 * nb, 64 * kb, 32 * nb, nullptr, 0, scr, F.lane); continue; } r -= I_IN;
        if (r < I_LORA) {
            int sub, rr;
            if (r < 128) { sub = r / 32; rr = r % 32; } else { sub = 4 + (r - 128) / 64; rr = (r - 128) % 64; }
            const int which = sub >> 1, isq = sub & 1, Nn = (which == 2) ? 128 : 64, nblk = Nn / 32, kb = rr / nblk, nb = rr % nblk;
            const float* W = (which == 0 ? F.in[I_W1] : which == 1 ? F.in[I_A1] : F.in[I_G1]) + (size_t)l * DM * Nn;
            const int dst = (which == 0 ? (isq ? C_QW : C_PW) : which == 1 ? (isq ? C_QA : C_PA) : (isq ? C_QG : C_PG)) + 32 * nb;
            transpose_item(W, DM, Nn, WIN, dst, 64 * kb, 32 * nb, mu + which * DM, isq ? 1 : 2, scr, F.lane); continue; } r -= I_LORA;
        if (r < I_O) { const int kb = r / 32, nb = r % 32; transpose_item(F.in[I_WO] + (size_t)l * DM * DM, DM, DM, WO, 32 * nb, 64 * kb, 32 * nb, nullptr, 0, scr, F.lane); continue; } r -= I_O;
        if (r < 2 * I_G) { const int up = r / I_G, q = r % I_G, kb = q / 88, nb = q % 88, n0 = 32 * nb;
            const float* W = (up ? F.in[I_WUP] : F.in[I_WGATE]) + (size_t)l * DM * FF;
            transpose_item(W, DM, FF, WGU, (n0 / 128) * 256 + (n0 % 128) + up * 128, 64 * kb, n0, nullptr, 0, scr, F.lane); continue; } r -= 2 * I_G;
        { const int kb = r / 32, nb = r % 32; transpose_item(F.in[I_WDOWN] + (size_t)l * FF * DM, FF, DM, WDN, 32 * nb, 64 * kb, 32 * nb, nullptr, 0, scr, F.lane); }
    }
}

__device__ __forceinline__ void store_row_bf16(bf16* orow, const f32x4 (&v)[4], float r, const float* g, int lane) {
    GAS unsigned long long* o8 = (GAS unsigned long long*)orow + lane;
#pragma unroll
    for (int j = 0; j < 4; ++j) { const f32x4 gg = *(const f32x4*)(g + 4 * lane + 256 * j);
        o8[64 * j] = (unsigned long long)pk2(v[j].x * r * gg.x, v[j].y * r * gg.y) | ((unsigned long long)pk2(v[j].z * r * gg.z, v[j].w * r * gg.w) << 32); }
}
__device__ __forceinline__ float row_sumsq(const f32x4 (&v)[4]) {
    float s = 0.f;
#pragma unroll
    for (int j = 0; j < 4; ++j) s += (v[j].x * v[j].x + v[j].y * v[j].y) + (v[j].z * v[j].z + v[j].w * v[j].w);
    return wave_sum(s);
}
__device__ __forceinline__ void phase_norm0(const Frame& F) {
    const int gw = F.blk * NWAVES + F.wave, NGW = F.G * NWAVES;
    bf16* H = (bf16*)(F.ws + WS_HA); const float* g = F.in[I_PREMIX];
    for (int m = gw; m < M; m += NGW) {
        const GAS f32x4* xr = (const GAS f32x4*)(F.in[I_X] + (size_t)m * DM) + F.lane;
        f32x4 v[4];
#pragma unroll
        for (int j = 0; j < 4; ++j) v[j] = xr[64 * j];
        const float r = rsqrtf(row_sumsq(v) * (1.f / DM) + NORM_EPS);
        store_row_bf16(H + (size_t)m * DM, v, r, g, F.lane);
    }
}
__device__ __forceinline__ void phase_norm_res(const Frame& F, const float* tmp, const float* xold, const float* g1, const float* g2) {
    const int gw = F.blk * NWAVES + F.wave, NGW = F.G * NWAVES;
    bf16* H = (bf16*)(F.ws + WS_HA);
    for (int m = gw; m < M; m += NGW) {
        const GAS f32x4* tr = (const GAS f32x4*)(tmp + (size_t)m * DM) + F.lane;
        const GAS f32x4* xr = (const GAS f32x4*)(xold + (size_t)m * DM) + F.lane;
        GAS f32x4* orow = (GAS f32x4*)(F.out + (size_t)m * DM) + F.lane;
        f32x4 v[4], x[4];
#pragma unroll
        for (int j = 0; j < 4; ++j) { v[j] = tr[64 * j]; x[j] = xr[64 * j]; }
        const float r = rsqrtf(row_sumsq(v) * (1.f / DM) + NORM_EPS);
#pragma unroll
        for (int j = 0; j < 4; ++j) { const f32x4 gg = *(const f32x4*)(g1 + 4 * F.lane + 256 * j); x[j] = x[j] + v[j] * r * gg; orow[64 * j] = x[j]; }
        if (g2) { const float r2 = rsqrtf(row_sumsq(x) * (1.f / DM) + NORM_EPS); store_row_bf16(H + (size_t)m * DM, x, r2, g2, F.lane); }
    }
}

__device__ __forceinline__ void phase_prep(const Frame& F, int l) {
    LAS float* lin = (LAS float*)F.lds;
    const int c = F.tid, hh = F.wave;
    const bf16* PROJ = (const bf16*)(F.ws + WS_PROJ);
    _Float16* LW = (_Float16*)(F.ws + WS_X1); bf16* KP = (bf16*)(F.ws + WS_X1 + 16 * MiB); bf16* KK = (bf16*)(F.ws + WS_X1 + 32 * MiB); bf16* BV = (bf16*)(F.ws + WS_X1 + 48 * MiB);
    bf16* RR = (bf16*)(F.ws + WS_HA + 16 * MiB); float* BON = (float*)(F.ws + WS_BON);
    const float w0c = F.in[I_W0][l * RW + c], a0c = F.in[I_A0][l * RW + c], kkc = F.in[I_KK][l * RW + c], kac = F.in[I_KA][l * RW + c], rkc = F.in[I_RK][l * RW + c];
    const float mur = F.in[I_MURKV][l * 3 * RW + c], muk = F.in[I_MURKV][l * 3 * RW + RW + c];
    float W2r[64], A2r[64];
#pragma unroll
    for (int j = 0; j < 64; ++j) { W2r[j] = F.in[I_W2][((size_t)l * 64 + j) * RW + c]; A2r[j] = F.in[I_A2][((size_t)l * 64 + j) * RW + c]; }
    for (int tile = F.blk; tile < M / 64; tile += F.G) {
        const int m0 = tile * 64;
        float rprev = 0.f, kprev = 0.f;
        if ((m0 % NT) != 0) { rprev = bf2f(PROJ[(size_t)(m0 - 1) * NP + C_R + c]); kprev = bf2f(PROJ[(size_t)(m0 - 1) * NP + C_K + c]); }
        for (int i = 0; i < 64; ++i) {
            const int m = m0 + i, t = m % NT, buf = (i & 1) * 128;
            if (c < 128) { const int j = c & 63, which = c >> 6;
                const float p = bf2f(PROJ[(size_t)m * NP + (which ? C_PA : C_PW) + j]);
                const float q = t > 0 ? bf2f(PROJ[(size_t)(m - 1) * NP + (which ? C_QA : C_QW) + j]) : 0.f;
                lin[buf + c] = which ? (p + q) : tanhf(p + q); }
            const float rp = bf2f(PROJ[(size_t)m * NP + C_R + c]), kp_ = bf2f(PROJ[(size_t)m * NP + C_K + c]);
            __syncthreads();
            float wp = w0c, ap = a0c;
#pragma unroll
            for (int j = 0; j < 64; j += 4) { const f32x4 lw4 = *(const LAS f32x4*)(lin + buf + j), la4 = *(const LAS f32x4*)(lin + buf + 64 + j);
                wp += lw4.x * W2r[j] + lw4.y * W2r[j + 1] + lw4.z * W2r[j + 2] + lw4.w * W2r[j + 3];
                ap += la4.x * A2r[j] + la4.y * A2r[j + 1] + la4.z * A2r[j + 2] + la4.w * A2r[j + 3]; }
            const float a = sigmoidf_(ap), lwv = -0.60653065971f * sigmoidf_(wp);
            const float r = rp + (rprev - rp) * mur, k = kp_ + (kprev - kp_) * muk;
            rprev = rp; kprev = kp_;
            const float kku = k * kkc, n2 = wave_sum(kku * kku);
            const float kk = kku / fmaxf(sqrtf(n2), 1e-12f);
            const float kpr = k * (1.0f + (a - 1.0f) * kac), bvv = kk * a;
            const float bon = wave_sum(r * kpr * rkc);
            const size_t o = (size_t)m * RW + c;
            LW[o] = (_Float16)lwv; KP[o] = (bf16)f2bf(kpr); KK[o] = (bf16)f2bf(kk); BV[o] = (bf16)f2bf(bvv); RR[o] = (bf16)f2bf(r);
            if (F.lane == 0) BON[(size_t)m * NH + hh] = bon;
        }
        __syncthreads();
    }
}

__device__ __forceinline__ void phase_scan(const Frame& F, int l) {
    if (F.wave >= 4) return;
    const bf16* PROJ = (const bf16*)(F.ws + WS_PROJ);
    const _Float16* LW = (const _Float16*)(F.ws + WS_X1); const bf16* KP = (const bf16*)(F.ws + WS_X1 + 16 * MiB); const bf16* KK = (const bf16*)(F.ws + WS_X1 + 32 * MiB); const bf16* BV = (const bf16*)(F.ws + WS_X1 + 48 * MiB);
    const bf16* RR = (const bf16*)(F.ws + WS_HA + 16 * MiB); bf16* Y = (bf16*)(F.ws + WS_HA);
    for (int item = F.blk; item < NB * NH * 4; item += F.G) {
        const int bh = item >> 2, rb = item & 3, b = bh >> 3, h = bh & 7;
        const int i = 16 * rb + 4 * F.wave + (F.lane >> 4), cg = F.lane & 15, ch = h * 64;
        const float muv = F.in[I_MURKV][l * 3 * RW + 2 * RW + ch + i];
        const size_t mb = (size_t)b * NT;
        const size_t cofs = ch + 4 * cg;
        float S0 = 0.f, S1 = 0.f, S2 = 0.f, S3 = 0.f, vprev = 0.f;
        for (int t0 = 0; t0 < NT; t0 += 8) {
            typedef _Float16 h4 __attribute__((ext_vector_type(4)));
            v2u kkr[8], bvr[8], kpr[8], rrr[8]; h4 lwr[8]; unsigned short vr[8];
#pragma unroll
            for (int s = 0; s < 8; ++s) { const size_t m = mb + t0 + s, o = m * RW + cofs;
                kkr[s] = *(const GAS v2u*)(KK + o); bvr[s] = *(const GAS v2u*)(BV + o); kpr[s] = *(const GAS v2u*)(KP + o); rrr[s] = *(const GAS v2u*)(RR + o);
                lwr[s] = *(const GAS h4*)(LW + o); vr[s] = PROJ[m * NP + C_V + ch + i]; }
#pragma unroll
            for (int s = 0; s < 8; ++s) {
                const float k0 = bflo(kkr[s].x), k1 = bfhi(kkr[s].x), k2 = bflo(kkr[s].y), k3 = bfhi(kkr[s].y);
                const float b0 = bflo(bvr[s].x), b1 = bfhi(bvr[s].x), b2 = bflo(bvr[s].y), b3 = bfhi(bvr[s].y);
                const float p0 = bflo(kpr[s].x), p1 = bfhi(kpr[s].x), p2 = bflo(kpr[s].y), p3 = bfhi(kpr[s].y);
                const float r0 = bflo(rrr[s].x), r1 = bfhi(rrr[s].x), r2 = bflo(rrr[s].y), r3 = bfhi(rrr[s].y);
                const float w0 = __expf((float)lwr[s].x), w1 = __expf((float)lwr[s].y), w2 = __expf((float)lwr[s].z), w3 = __expf((float)lwr[s].w);
                const float vc = bf2f(vr[s]); const float v = vc + (vprev - vc) * muv; vprev = vc;
                const float sa = -allreduce16((S0 * k0 + S1 * k1) + (S2 * k2 + S3 * k3));
                S0 = S0 * w0 + (sa * b0 + v * p0); S1 = S1 * w1 + (sa * b1 + v * p1); S2 = S2 * w2 + (sa * b2 + v * p2); S3 = S3 * w3 + (sa * b3 + v * p3);
                const float y = allreduce16((S0 * r0 + S1 * r1) + (S2 * r2 + S3 * r3));
                if (cg == 0) Y[(mb + t0 + s) * RW + ch + i] = (bf16)f2bf(y);
            }
        }
    }
}


__device__ __forceinline__ void phase_scan2(const Frame& F, int l) {
    constexpr int CH = 16, STEPF = 336, BUFF = CH * STEPF;
    constexpr int YPF = CH * 16 * 16;
    LAS float* ring = (LAS float*)F.lds;
    LAS float* ypart = (LAS float*)(F.lds + 2 * BUFF * 4);
    const bf16* PROJ = (const bf16*)(F.ws + WS_PROJ);
    const _Float16* LW = (const _Float16*)(F.ws + WS_X1); const bf16* KP = (const bf16*)(F.ws + WS_X1 + 16 * MiB); const bf16* KK = (const bf16*)(F.ws + WS_X1 + 32 * MiB); const bf16* BV = (const bf16*)(F.ws + WS_X1 + 48 * MiB);
    const bf16* RR = (const bf16*)(F.ws + WS_HA + 16 * MiB); bf16* Y = (bf16*)(F.ws + WS_HA);
    typedef _Float16 h4 __attribute__((ext_vector_type(4)));
    for (int item = F.blk; item < NB * NH * 4; item += F.G) {
        const int bh = item >> 2, rb = item & 3, b = bh >> 3, h = bh & 7, ch = h * 64;
        const size_t mb = (size_t)b * NT;
        const bool scanner = F.wave < 4;
        const int lid = (F.wave - 4) * 64 + F.lane;
        const int iloc = 4 * F.wave + (F.lane >> 4), cg = F.lane & 15;
        const float muv = F.in[I_MURKV][l * 3 * RW + 2 * RW + ch + 16 * rb + (F.lane & 15)];
        f32x4 S = {0.f, 0.f, 0.f, 0.f};
        auto fill = [&](int c) {
            LAS float* dst = ring + (c & 1) * BUFF; const int t0 = c * CH;
            v2u raw[5];
#pragma unroll
            for (int k = 0; k < 5; ++k) { const int s = lid >> 4, g = lid & 15;
                const size_t o = (mb + t0 + s) * RW + ch + 4 * g;
                const void* src_ = k == 0 ? (const void*)(LW + o) : k == 1 ? (const void*)(KK + o) : k == 2 ? (const void*)(BV + o) : k == 3 ? (const void*)(KP + o) : (const void*)(RR + o);
                raw[k] = *(const GAS v2u*)src_; }
            const int sv = lid >> 4, rv = lid & 15, tv = t0 + sv;
            const bf16* pv = PROJ + (mb + tv) * NP + C_V + ch + 16 * rb + rv; const unsigned short vc = pv[0], vp = tv > 0 ? pv[-NP] : (unsigned short)0;
#pragma unroll
            for (int k = 0; k < 5; ++k) { const int s = lid >> 4, g = lid & 15;
                f32x4 o;
                if (k == 0) { const h4 hv = __builtin_bit_cast(h4, raw[k]); o.x = __expf((float)hv.x); o.y = __expf((float)hv.y); o.z = __expf((float)hv.z); o.w = __expf((float)hv.w); }
                else { o.x = bflo(raw[k].x); o.y = bfhi(raw[k].x); o.z = bflo(raw[k].y); o.w = bfhi(raw[k].y); }
                *(LAS f32x4*)(dst + s * STEPF + k * 64 + 4 * g) = o; }
            { const float c_ = bf2f(vc), p_ = bf2f(vp); dst[sv * STEPF + 320 + rv] = c_ + (p_ - c_) * muv; }
        };
        auto yout = [&](int c) {
            const LAS float* yp = ypart + (c & 1) * YPF + lid * 16; const int t0 = c * CH;
            const f32x4 a0 = *(const LAS f32x4*)(yp), a1 = *(const LAS f32x4*)(yp + 4), a2 = *(const LAS f32x4*)(yp + 8), a3 = *(const LAS f32x4*)(yp + 12);
            const f32x4 t = (a0 + a1) + (a2 + a3);
            Y[(mb + t0 + (lid >> 4)) * RW + ch + 16 * rb + (lid & 15)] = (bf16)f2bf((t.x + t.y) + (t.z + t.w));
        };
        if (!scanner) fill(0);
        __syncthreads();
        for (int c = 0; c < NT / CH; ++c) {
            if (scanner) {
                const LAS float* src = ring + (c & 1) * BUFF + 4 * cg; const LAS float* vsrc = ring + (c & 1) * BUFF + 320 + iloc;
                LAS float* yp = ypart + (c & 1) * YPF + iloc * 16 + cg;
                f32x4 w4 = *(const LAS f32x4*)(src), k4 = *(const LAS f32x4*)(src + 64), b4 = *(const LAS f32x4*)(src + 128), p4 = *(const LAS f32x4*)(src + 192), r4 = *(const LAS f32x4*)(src + 256);
                float v = vsrc[0];
#pragma unroll
                for (int s = 0; s < CH; ++s) {
                    f32x4 w4n, k4n, b4n, p4n, r4n; float vn;
                    if (s + 1 < CH) { const LAS float* p = src + (s + 1) * STEPF;
                        w4n = *(const LAS f32x4*)(p); k4n = *(const LAS f32x4*)(p + 64); b4n = *(const LAS f32x4*)(p + 128); p4n = *(const LAS f32x4*)(p + 192); r4n = *(const LAS f32x4*)(p + 256); vn = vsrc[(s + 1) * STEPF]; }
                    const float sa = -allreduce16((S.x * k4.x + S.y * k4.y) + (S.z * k4.z + S.w * k4.w));
                    S = S * w4 + (b4 * sa + p4 * v);
                    yp[s * 256] = (S.x * r4.x + S.y * r4.y) + (S.z * r4.z + S.w * r4.w);
                    if (s + 1 < CH) { w4 = w4n; k4 = k4n; b4 = b4n; p4 = p4n; r4 = r4n; v = vn; }
                }
            } else {
                if (c + 1 < NT / CH) fill(c + 1);
                if (c >= 1) yout(c - 1);
            }
            __syncthreads();
        }
        if (!scanner) yout(NT / CH - 1);
        __syncthreads();
    }
}
__device__ __forceinline__ void phase_scan_simple(const Frame& F, int l) {
    if (F.wave >= 1 || F.blk >= NB * NH) return;
    LAS float* sh = (LAS float*)F.lds;
    const bf16* PROJ = (const bf16*)(F.ws + WS_PROJ);
    const _Float16* LW = (const _Float16*)(F.ws + WS_X1); const bf16* KP = (const bf16*)(F.ws + WS_X1 + 16 * MiB); const bf16* KK = (const bf16*)(F.ws + WS_X1 + 32 * MiB); const bf16* BV = (const bf16*)(F.ws + WS_X1 + 48 * MiB);
    const bf16* RR = (const bf16*)(F.ws + WS_HA + 16 * MiB); bf16* Y = (bf16*)(F.ws + WS_HA);
    const int b = F.blk >> 3, h = F.blk & 7, lane = F.lane, c = h * 64 + lane;
    const float muv = F.in[I_MURKV][l * 3 * RW + 2 * RW + c];
    float S[64];
#pragma unroll
    for (int j = 0; j < 64; ++j) S[j] = 0.f;
    float vprev = 0.f;
    for (int t = 0; t < NT; ++t) {
        const size_t m = (size_t)b * NT + t, o = m * RW + c;
        sh[lane] = __expf((float)LW[o]); sh[64 + lane] = bf2f(KK[o]); sh[128 + lane] = bf2f(BV[o]); sh[192 + lane] = bf2f(KP[o]); sh[256 + lane] = bf2f(RR[o]);
        const float vc = bf2f(PROJ[m * NP + C_V + c]); const float v = vc + (vprev - vc) * muv; vprev = vc;
        LDS_WAIT(); asm volatile("" ::: "memory");
        float sa = 0.f;
#pragma unroll
        for (int j = 0; j < 64; ++j) sa -= S[j] * sh[64 + j];
        float y = 0.f;
#pragma unroll
        for (int j = 0; j < 64; ++j) { S[j] = S[j] * sh[j] + sa * sh[128 + j] + v * sh[192 + j]; y += S[j] * sh[256 + j]; }
        Y[o] = (bf16)f2bf(y);
        LDS_WAIT(); asm volatile("" ::: "memory");
    }
}
__device__ __forceinline__ void phase_post(const Frame& F, int l) {
    LAS float* lin = (LAS float*)F.lds;
    const int c = F.tid, hh = F.wave;
    const bf16* PROJ = (const bf16*)(F.ws + WS_PROJ); const bf16* Y = (const bf16*)(F.ws + WS_HA); const float* BON = (const float*)(F.ws + WS_BON);
    bf16* MIX = (bf16*)(F.ws + WS_HB);
    const float lg_ = F.in[I_LNXG][l * RW + c], lb_ = F.in[I_LNXB][l * RW + c], muv = F.in[I_MURKV][l * 3 * RW + 2 * RW + c];
    int hhv = c >> 6; asm volatile("" : "+v"(hhv));
    float G2r[128];
#pragma unroll
    for (int j = 0; j < 128; ++j) G2r[j] = F.in[I_G2][((size_t)l * 128 + j) * RW + c];
    for (int tile = F.blk; tile < M / 64; tile += F.G) {
        const int m0 = tile * 64;
        float vprev = 0.f;
        if ((m0 % NT) != 0) vprev = bf2f(PROJ[(size_t)(m0 - 1) * NP + C_V + c]);
        for (int i = 0; i < 64; ++i) {
            const int m = m0 + i, t = m % NT, buf = (i & 1) * 128;
            if (c < 128) { const float p = bf2f(PROJ[(size_t)m * NP + C_PG + c]); const float q = t > 0 ? bf2f(PROJ[(size_t)(m - 1) * NP + C_QG + c]) : 0.f; lin[buf + c] = sigmoidf_(p + q); }
            const float vc = bf2f(PROJ[(size_t)m * NP + C_V + c]); const float y = bf2f(Y[(size_t)m * RW + c]); const float bon = BON[(size_t)m * NH + hhv];
            __syncthreads();
            float g = 0.f;
#pragma unroll
            for (int j = 0; j < 128; j += 4) { const f32x4 l4 = *(const LAS f32x4*)(lin + buf + j); g += l4.x * G2r[j] + l4.y * G2r[j + 1] + l4.z * G2r[j + 2] + l4.w * G2r[j + 3]; }
            const float v = vc + (vprev - vc) * muv; vprev = vc;
            const float mean = wave_sum(y) * (1.f / 64.f), d = y - mean, var = wave_sum(d * d) * (1.f / 64.f);
            const float yn = d * rsqrtf(var + GN_EPS) * lg_ + lb_ + bon * v;
            MIX[(size_t)m * DM + c] = (bf16)f2bf(yn * g);
        }
        __syncthreads();
    }
}
__device__ __forceinline__ void phase_sc(const Frame& F, int l) {
    const bf16* PROJ = (const bf16*)(F.ws + WS_PROJ); bf16* MIX = (bf16*)(F.ws + WS_HB);
    const int c = F.tid & 255, sub = F.tid >> 8;
    const float w0 = F.in[I_SCW][(l * 3 + 0) * 256 + c], w1 = F.in[I_SCW][(l * 3 + 1) * 256 + c], w2 = F.in[I_SCW][(l * 3 + 2) * 256 + c];
    for (int m = F.blk * 2 + sub; m < M; m += F.G * 2) {
        const int t = m % NT; const bf16* p = PROJ + (size_t)m * NP;
        float acc = w2 * bf2f(p[C_SCC + c]) * bf2f(p[C_SCU + c]);
        if (t >= 1) acc += w1 * bf2f(p[C_SCC + c - NP]) * bf2f(p[C_SCU + c - NP]);
        if (t >= 2) acc += w0 * bf2f(p[C_SCC + c - 2 * NP]) * bf2f(p[C_SCU + c - 2 * NP]);
        MIX[(size_t)m * DM + 512 + c] = (bf16)f2bf(bf2f(p[C_SCB + c]) * acc);
    }
}
__device__ __forceinline__ void phase_cf(const Frame& F, int l) {
    const bf16* PROJ = (const bf16*)(F.ws + WS_PROJ); bf16* MIX = (bf16*)(F.ws + WS_HB);
    LAS float* U = (LAS float*)F.lds;
    LAS float* CT = (LAS float*)(F.lds + 62 * 256 * 4);
    const int c = F.tid & 255, half = F.tid >> 8;
    float wr[31];
#pragma unroll
    for (int k = 0; k < 31; ++k) wr[k] = F.in[I_CFW][((size_t)l * 31 + k) * 256 + c];
    const float cb = F.in[I_CFB][l * 256 + c];
    const f32x4 lng = *(const f32x4*)(F.in[I_CFLG] + l * 256 + 4 * F.lane), lnb = *(const f32x4*)(F.in[I_CFLB] + l * 256 + 4 * F.lane);
    for (int tile = F.blk; tile < M / 32; tile += F.G) {
        const int m0 = tile * 32, t0 = m0 % NT;
        for (int idx = F.tid; idx < 62 * 256; idx += NTHR) { const int rr = idx >> 8, cc = idx & 255; const int tt = t0 - 30 + rr;
            float u = 0.f;
            if (tt >= 0) { const bf16* p = PROJ + (size_t)(m0 - 30 + rr) * NP; u = bf2f(p[C_CFV + cc]) * sigmoidf_(bf2f(p[C_CFG + cc])); }
            U[idx] = u; }
        __syncthreads();
#pragma unroll 1
        for (int ii = 0; ii < 16; ++ii) { const int i = half * 16 + ii; float acc = cb;
#pragma unroll
            for (int k = 0; k < 31; ++k) acc += wr[k] * U[(i + k) * 256 + c];
            CT[i * 256 + c] = acc; }
        __syncthreads();
#pragma unroll 1
        for (int q = 0; q < 4; ++q) { const int i = F.wave * 4 + q;
            const f32x4 x = *(const LAS f32x4*)(CT + i * 256 + 4 * F.lane);
            const float mean = wave_sum((x.x + x.y) + (x.z + x.w)) * (1.f / 256.f);
            const f32x4 d = x - mean;
            const float var = wave_sum((d.x * d.x + d.y * d.y) + (d.z * d.z + d.w * d.w)) * (1.f / 256.f);
            const float rs = rsqrtf(var + LN_EPS);
            f32x4 y = d * rs * lng + lnb;
            y.x = y.x * sigmoidf_(y.x); y.y = y.y * sigmoidf_(y.y); y.z = y.z * sigmoidf_(y.z); y.w = y.w * sigmoidf_(y.w);
            *(GAS unsigned long long*)(MIX + (size_t)(m0 + i) * DM + 768 + 4 * F.lane) = (unsigned long long)pk2(y.x, y.y) | ((unsigned long long)pk2(y.z, y.w) << 32); }
        __syncthreads();
    }
}


__device__ __forceinline__ void phase_prep2(const Frame& F, int l) {
    const int hd = F.wave, lane = F.lane, c = hd * 64 + lane, n = lane & 31, hh = lane >> 5;
    LAS float* Tw = (LAS float*)(F.lds + F.wave * 16384); LAS float* Ta = Tw + 2048;
    const bf16* PROJ = (const bf16*)(F.ws + WS_PROJ);
    _Float16* LW = (_Float16*)(F.ws + WS_X1); bf16* KP = (bf16*)(F.ws + WS_X1 + 16 * MiB); bf16* KK = (bf16*)(F.ws + WS_X1 + 32 * MiB); bf16* BV = (bf16*)(F.ws + WS_X1 + 48 * MiB);
    bf16* RR = (bf16*)(F.ws + WS_HA + 16 * MiB); float* BON = (float*)(F.ws + WS_BON);
    const float w0c = F.in[I_W0][l * RW + c], a0c = F.in[I_A0][l * RW + c], kkc = F.in[I_KK][l * RW + c], kac = F.in[I_KA][l * RW + c], rkc = F.in[I_RK][l * RW + c];
    const float mur = F.in[I_MURKV][l * 3 * RW + c], muk = F.in[I_MURKV][l * 3 * RW + RW + c];
    bf16x8 Bw[4][2], Ba[4][2];
#pragma unroll
    for (int s = 0; s < 4; ++s)
#pragma unroll
        for (int nb = 0; nb < 2; ++nb)
#pragma unroll
            for (int j = 0; j < 8; ++j) { const size_t o = ((size_t)l * 64 + 16 * s + 8 * hh + j) * RW + hd * 64 + 32 * nb + n;
                Bw[s][nb][j] = (short)f2bf(F.in[I_W2][o]); Ba[s][nb][j] = (short)f2bf(F.in[I_A2][o]); }
    for (int tile = F.blk; tile < M / 64; tile += F.G) {
#pragma unroll 1
        for (int half = 0; half < 2; ++half) {
            const int m0 = tile * 64 + half * 32;
            {
                const int tok = m0 + n, t = tok % NT; const bf16* pp = PROJ + (size_t)tok * NP + 8 * hh;
                f32x16 accw[2], acca[2];
#pragma unroll
                for (int nb = 0; nb < 2; ++nb)
#pragma unroll
                    for (int r = 0; r < 16; ++r) { accw[nb][r] = 0.f; acca[nb][r] = 0.f; }
#pragma unroll
                for (int s = 0; s < 4; ++s) {
                    const v4u pw = *(const GAS v4u*)(pp + C_PW + 16 * s), pa = *(const GAS v4u*)(pp + C_PA + 16 * s);
                    v4u qw = {0u, 0u, 0u, 0u}, qa = {0u, 0u, 0u, 0u};
                    if (t > 0) { qw = *(const GAS v4u*)(pp - NP + C_QW + 16 * s); qa = *(const GAS v4u*)(pp - NP + C_QA + 16 * s); }
                    v4u aw, aa;
#pragma unroll
                    for (int e = 0; e < 4; ++e) { aw[e] = pk2(tanh_fast(bflo(pw[e]) + bflo(qw[e])), tanh_fast(bfhi(pw[e]) + bfhi(qw[e]))); aa[e] = pk2(bflo(pa[e]) + bflo(qa[e]), bfhi(pa[e]) + bfhi(qa[e])); }
                    const bf16x8 Aw = __builtin_bit_cast(bf16x8, aw), Aa = __builtin_bit_cast(bf16x8, aa);
#pragma unroll
                    for (int nb = 0; nb < 2; ++nb) { accw[nb] = MFMA32(Aw, Bw[s][nb], accw[nb]); acca[nb] = MFMA32(Aa, Ba[s][nb], acca[nb]); }
                }
#pragma unroll
                for (int nb = 0; nb < 2; ++nb)
#pragma unroll
                    for (int r = 0; r < 16; ++r) { Tw[crow(r, hh) * 64 + 32 * nb + n] = accw[nb][r]; Ta[crow(r, hh) * 64 + 32 * nb + n] = acca[nb][r]; }
            }
            LDS_WAIT(); asm volatile("" ::: "memory");
            float rprev = 0.f, kprev = 0.f;
            if ((m0 % NT) != 0) { rprev = bf2f(PROJ[(size_t)(m0 - 1) * NP + C_R + c]); kprev = bf2f(PROJ[(size_t)(m0 - 1) * NP + C_K + c]); }
#pragma unroll 4
            for (int i = 0; i < 32; ++i) {
                const int m = m0 + i;
                const float rp = bf2f(PROJ[(size_t)m * NP + C_R + c]), kp_ = bf2f(PROJ[(size_t)m * NP + C_K + c]);
                const float wp = w0c + Tw[i * 64 + lane], ap = a0c + Ta[i * 64 + lane];
                const float a = sigm_fast(ap), lwv = -0.60653065971f * sigm_fast(wp);
                const float r = rp + (rprev - rp) * mur, k = kp_ + (kprev - kp_) * muk;
                rprev = rp; kprev = kp_;
                const float kku = k * kkc, kpr = k * (1.0f + (a - 1.0f) * kac);
                const float n2 = wave_allsum(kku * kku), bon = wave_allsum(r * kpr * rkc);
                const float kk = kku / fmaxf(sqrtf(n2), 1e-12f), bvv = kk * a;
                const size_t o = (size_t)m * RW + c;
                LW[o] = (_Float16)lwv; KP[o] = (bf16)f2bf(kpr); KK[o] = (bf16)f2bf(kk); BV[o] = (bf16)f2bf(bvv); RR[o] = (bf16)f2bf(r);
                if (lane == 0) BON[(size_t)m * NH + hd] = bon;
            }
            LDS_WAIT(); asm volatile("" ::: "memory");
        }
    }
}
__device__ __forceinline__ void phase_post2(const Frame& F, int l) {
    const int hd = F.wave, lane = F.lane, c = hd * 64 + lane, n = lane & 31, hh = lane >> 5;
    LAS float* Tg = (LAS float*)(F.lds + F.wave * 16384);
    const bf16* PROJ = (const bf16*)(F.ws + WS_PROJ); const bf16* Y = (const bf16*)(F.ws + WS_HA); const float* BON = (const float*)(F.ws + WS_BON);
    bf16* MIX = (bf16*)(F.ws + WS_HB);
    const float lg_ = F.in[I_LNXG][l * RW + c], lb_ = F.in[I_LNXB][l * RW + c], muv = F.in[I_MURKV][l * 3 * RW + 2 * RW + c];
    int hhv = c >> 6; asm volatile("" : "+v"(hhv));
    bf16x8 Bg[8][2];
#pragma unroll
    for (int s = 0; s < 8; ++s)
#pragma unroll
        for (int nb = 0; nb < 2; ++nb)
#pragma unroll
            for (int j = 0; j < 8; ++j) Bg[s][nb][j] = (short)f2bf(F.in[I_G2][((size_t)l * 128 + 16 * s + 8 * hh + j) * RW + hd * 64 + 32 * nb + n]);
    for (int tile = F.blk; tile < M / 64; tile += F.G) {
#pragma unroll 1
        for (int half = 0; half < 2; ++half) {
            const int m0 = tile * 64 + half * 32;
            {
                const int tok = m0 + n, t = tok % NT; const bf16* pp = PROJ + (size_t)tok * NP + 8 * hh;
                f32x16 accg[2];
#pragma unroll
                for (int nb = 0; nb < 2; ++nb)
#pragma unroll
                    for (int r = 0; r < 16; ++r) accg[nb][r] = 0.f;
#pragma unroll
                for (int s = 0; s < 8; ++s) {
                    const v4u pg = *(const GAS v4u*)(pp + C_PG + 16 * s);
                    v4u qg = {0u, 0u, 0u, 0u};
                    if (t > 0) qg = *(const GAS v4u*)(pp - NP + C_QG + 16 * s);
                    v4u ag;
#pragma unroll
                    for (int e = 0; e < 4; ++e) ag[e] = pk2(sigm_fast(bflo(pg[e]) + bflo(qg[e])), sigm_fast(bfhi(pg[e]) + bfhi(qg[e])));
                    const bf16x8 Ag = __builtin_bit_cast(bf16x8, ag);
#pragma unroll
                    for (int nb = 0; nb < 2; ++nb) accg[nb] = MFMA32(Ag, Bg[s][nb], accg[nb]);
                }
#pragma unroll
                for (int nb = 0; nb < 2; ++nb)
#pragma unroll
                    for (int r = 0; r < 16; ++r) Tg[crow(r, hh) * 64 + 32 * nb + n] = accg[nb][r];
            }
            LDS_WAIT(); asm volatile("" ::: "memory");
            float vprev = 0.f;
            if ((m0 % NT) != 0) vprev = bf2f(PROJ[(size_t)(m0 - 1) * NP + C_V + c]);
#pragma unroll 4
            for (int i = 0; i < 32; ++i) {
                const int m = m0 + i;
                const float vc = bf2f(PROJ[(size_t)m * NP + C_V + c]); const float y = bf2f(Y[(size_t)m * RW + c]); const float bon = BON[(size_t)m * NH + hhv];
                const float g = Tg[i * 64 + lane];
                const float v = vc + (vprev - vc) * muv; vprev = vc;
                const float mean = wave_allsum(y) * (1.f / 64.f), d = y - mean, var = wave_allsum(d * d) * (1.f / 64.f);
                const float yn = d * rsqrtf(var + GN_EPS) * lg_ + lb_ + bon * v;
                MIX[(size_t)m * DM + c] = (bf16)f2bf(yn * g);
            }
            LDS_WAIT(); asm volatile("" ::: "memory");
        }
    }
}
__device__ __forceinline__ void phase_sc2(const Frame& F, int l) {
    const bf16* PROJ = (const bf16*)(F.ws + WS_PROJ); bf16* MIX = (bf16*)(F.ws + WS_HB);
    const int g = F.tid & 31, sub = F.tid >> 5, c0 = 8 * g;
    float w0[8], w1[8], w2[8];
#pragma unroll
    for (int e = 0; e < 8; ++e) { w0[e] = F.in[I_SCW][(l * 3 + 0) * 256 + c0 + e]; w1[e] = F.in[I_SCW][(l * 3 + 1) * 256 + c0 + e]; w2[e] = F.in[I_SCW][(l * 3 + 2) * 256 + c0 + e]; }
    for (int m = F.blk * 16 + sub; m < M; m += F.G * 16) {
        const int t = m % NT; const bf16* p = PROJ + (size_t)m * NP + c0;
        const v4u B = *(const GAS v4u*)(p + C_SCB), C0 = *(const GAS v4u*)(p + C_SCC), U0 = *(const GAS v4u*)(p + C_SCU);
        v4u C1 = {0u, 0u, 0u, 0u}, U1 = C1, C2 = C1, U2 = C1;
        if (t >= 1) { C1 = *(const GAS v4u*)(p - NP + C_SCC); U1 = *(const GAS v4u*)(p - NP + C_SCU); }
        if (t >= 2) { C2 = *(const GAS v4u*)(p - 2 * NP + C_SCC); U2 = *(const GAS v4u*)(p - 2 * NP + C_SCU); }
        v4u o;
#pragma unroll
        for (int e = 0; e < 4; ++e) {
            const float lo = bflo(B[e]) * (w2[2 * e] * bflo(C0[e]) * bflo(U0[e]) + w1[2 * e] * bflo(C1[e]) * bflo(U1[e]) + w0[2 * e] * bflo(C2[e]) * bflo(U2[e]));
            const float hi = bfhi(B[e]) * (w2[2 * e + 1] * bfhi(C0[e]) * bfhi(U0[e]) + w1[2 * e + 1] * bfhi(C1[e]) * bfhi(U1[e]) + w0[2 * e + 1] * bfhi(C2[e]) * bfhi(U2[e]));
            o[e] = pk2(lo, hi); }
        *(GAS v4u*)(MIX + (size_t)m * DM + 512 + c0) = o;
    }
}
__device__ __forceinline__ void phase_cf2(const Frame& F, int l) {
    const bf16* PROJ = (const bf16*)(F.ws + WS_PROJ); bf16* MIX = (bf16*)(F.ws + WS_HB);
    LAS float* U = (LAS float*)F.lds;
    LAS float* CT = (LAS float*)(F.lds + 62 * 256 * 4);
    const int c = F.tid & 255, half = F.tid >> 8;
    float wr[31];
#pragma unroll
    for (int k = 0; k < 31; ++k) wr[k] = F.in[I_CFW][((size_t)l * 31 + k) * 256 + c];
    const float cb = F.in[I_CFB][l * 256 + c];
    const f32x4 lng = *(const f32x4*)(F.in[I_CFLG] + l * 256 + 4 * F.lane), lnb = *(const f32x4*)(F.in[I_CFLB] + l * 256 + 4 * F.lane);
    for (int tile = F.blk; tile < M / 32; tile += F.G) {
        const int m0 = tile * 32, t0 = m0 % NT;
        for (int idx = F.tid; idx < 62 * 32; idx += NTHR) { const int rr = idx >> 5, g8 = (idx & 31) * 8; const int tt = t0 - 30 + rr;
            f32x4 u0 = {0.f, 0.f, 0.f, 0.f}, u1 = u0;
            if (tt >= 0) { const bf16* p = PROJ + (size_t)(m0 - 30 + rr) * NP + g8; const v4u vv = *(const GAS v4u*)(p + C_CFV), gg = *(const GAS v4u*)(p + C_CFG);
                u0.x = bflo(vv.x) * sigm_fast(bflo(gg.x)); u0.y = bfhi(vv.x) * sigm_fast(bfhi(gg.x)); u0.z = bflo(vv.y) * sigm_fast(bflo(gg.y)); u0.w = bfhi(vv.y) * sigm_fast(bfhi(gg.y));
                u1.x = bflo(vv.z) * sigm_fast(bflo(gg.z)); u1.y = bfhi(vv.z) * sigm_fast(bfhi(gg.z)); u1.z = bflo(vv.w) * sigm_fast(bflo(gg.w)); u1.w = bfhi(vv.w) * sigm_fast(bfhi(gg.w)); }
            *(LAS f32x4*)(U + rr * 256 + g8) = u0; *(LAS f32x4*)(U + rr * 256 + g8 + 4) = u1; }
        __syncthreads();
#pragma unroll 2
        for (int ii = 0; ii < 16; ++ii) { const int i = half * 16 + ii; float acc = cb;
#pragma unroll
            for (int k = 0; k < 31; ++k) acc += wr[k] * U[(i + k) * 256 + c];
            CT[i * 256 + c] = acc; }
        __syncthreads();
#pragma unroll 1
        for (int q = 0; q < 4; ++q) { const int i = F.wave * 4 + q;
            const f32x4 x = *(const LAS f32x4*)(CT + i * 256 + 4 * F.lane);
            const float mean = wave_allsum((x.x + x.y) + (x.z + x.w)) * (1.f / 256.f);
            const f32x4 d = x - mean;
            const float var = wave_allsum((d.x * d.x + d.y * d.y) + (d.z * d.z + d.w * d.w)) * (1.f / 256.f);
            const float rs = rsqrtf(var + LN_EPS);
            f32x4 y = d * rs * lng + lnb;
            y.x = y.x * sigm_fast(y.x); y.y = y.y * sigm_fast(y.y); y.z = y.z * sigm_fast(y.z); y.w = y.w * sigm_fast(y.w);
            *(GAS unsigned long long*)(MIX + (size_t)(m0 + i) * DM + 768 + 4 * F.lane) = (unsigned long long)pk2(y.x, y.y) | ((unsigned long long)pk2(y.z, y.w) << 32); }
        __syncthreads();
    }
}
#if DIAG
#ifndef DIAG_L
#define DIAG_L 0
#endif
__device__ __forceinline__ void diag_acc(unsigned char* ws, int id, float num, float den) {
    float* D = (float*)(ws + WS_CTL + 32768);
    num = wave_sum(num); den = wave_sum(den);
    if ((threadIdx.x & 63) == 0) { atomicAdd(D + 2 * id, num); atomicAdd(D + 2 * id + 1, den); }
}
__device__ __forceinline__ float dg_lora_w(const Args& a, int l, int k, int c) {
    int q = c - C_PW; const int isq = q >= 256; q -= isq * 256;
    const int which = q < 64 ? 0 : q < 128 ? 1 : 2, j = which == 0 ? q : which == 1 ? q - 64 : q - 128, Nn = which == 2 ? 128 : 64;
    const float* W = (which == 0 ? a.in[I_W1] : which == 1 ? a.in[I_A1] : a.in[I_G1]) + (size_t)l * DM * Nn;
    const float mu = a.in[I_MUWAG][(size_t)l * 3 * DM + which * DM + k];
    return W[(size_t)k * Nn + j] * (isq ? mu : 1.0f - mu);
}
__global__ void __launch_bounds__(512) diag_proj(Args a, int l) {
    __shared__ float hrow[DM];
    const int m = blockIdx.x * 257, tid = threadIdx.x;
    const bf16* HA = (const bf16*)(a.ws + WS_HA); const bf16* PROJ = (const bf16*)(a.ws + WS_PROJ);
    for (int k = tid; k < DM; k += 512) hrow[k] = bf2f(HA[(size_t)m * DM + k]);
    __syncthreads();
    float n0 = 0.f, d0 = 0.f, n1 = 0.f, d1 = 0.f;
    for (int c = tid; c < NP; c += 512) {
        float ref = 0.f;
        if (c < INW) { const float* W = a.in[I_WIN] + (size_t)l * DM * INW + c; for (int k = 0; k < DM; ++k) ref += hrow[k] * W[(size_t)k * INW]; }
        else for (int k = 0; k < DM; ++k) ref += hrow[k] * dg_lora_w(a, l, k, c);
        const float got = bf2f(PROJ[(size_t)m * NP + c]), e = ref - got;
        if (c < INW) { n0 += e * e; d0 += ref * ref; } else { n1 += e * e; d1 += ref * ref; }
    }
    diag_acc(a.ws, 0, n0, d0); diag_acc(a.ws, 1, n1, d1);
}
__global__ void __launch_bounds__(64) diag_y(Args a, int l) {
    __shared__ float sh[5][64]; __shared__ float sh2[5][64]; __shared__ float lin[128];
    const int b = blockIdx.x, h = blockIdx.x, lane = threadIdx.x, c = h * 64 + lane;
    const bf16* PROJ = (const bf16*)(a.ws + WS_PROJ); const bf16* Y = (const bf16*)(a.ws + WS_HA);
    const float w0c = a.in[I_W0][l * RW + c], a0c = a.in[I_A0][l * RW + c], kkc = a.in[I_KK][l * RW + c], kac = a.in[I_KA][l * RW + c];
    const float mur = a.in[I_MURKV][l * 3 * RW + c], muk = a.in[I_MURKV][l * 3 * RW + RW + c], muv = a.in[I_MURKV][l * 3 * RW + 2 * RW + c];
    float S[64];
#pragma unroll
    for (int j = 0; j < 64; ++j) S[j] = 0.f;
    float rprev = 0.f, kprev = 0.f, vprev = 0.f, num = 0.f, den = 0.f, num2 = 0.f, den2 = 0.f, pn[5] = {0.f, 0.f, 0.f, 0.f, 0.f}, pd[5] = {0.f, 0.f, 0.f, 0.f, 0.f};
    float S2[64];
#pragma unroll
    for (int j = 0; j < 64; ++j) S2[j] = 0.f;
    for (int t = 0; t < NT; ++t) {
        const size_t m = (size_t)b * NT + t; const bf16* p = PROJ + m * NP;
        float pw = bf2f(p[C_PW + lane]), pa = bf2f(p[C_PA + lane]);
        if (t > 0) { pw += bf2f(p[C_QW + lane - NP]); pa += bf2f(p[C_QA + lane - NP]); }
        lin[lane] = tanhf(pw); lin[64 + lane] = pa;
        __syncthreads();
        float wp = w0c, ap = a0c;
        for (int j = 0; j < 64; ++j) { wp += lin[j] * a.in[I_W2][((size_t)l * 64 + j) * RW + c]; ap += lin[64 + j] * a.in[I_A2][((size_t)l * 64 + j) * RW + c]; }
        const float av = 1.f / (1.f + expf(-ap)), w = expf(-0.60653065971f / (1.f + expf(-wp)));
        const float rp = bf2f(p[C_R + c]), kp_ = bf2f(p[C_K + c]), vp = bf2f(p[C_V + c]);
        const float r = rp + (rprev - rp) * mur, k = kp_ + (kprev - kp_) * muk, v = vp + (vprev - vp) * muv;
        rprev = rp; kprev = kp_; vprev = vp;
        const float kku = k * kkc; const float kk = kku / fmaxf(sqrtf(wave_sum(kku * kku)), 1e-12f);
        sh[0][lane] = w; sh[1][lane] = kk; sh[2][lane] = kk * av; sh[3][lane] = k * (1.f + (av - 1.f) * kac); sh[4][lane] = r;
        { const size_t o = m * RW + c;
          const float gw = expf((float)((const _Float16*)(a.ws + WS_X1))[o]), gkp = bf2f(((const bf16*)(a.ws + WS_X1 + 16 * MiB))[o]), gkk = bf2f(((const bf16*)(a.ws + WS_X1 + 32 * MiB))[o]);
          const float gbv = bf2f(((const bf16*)(a.ws + WS_X1 + 48 * MiB))[o]), grr = bf2f(((const bf16*)(a.ws + WS_HA + 16 * MiB))[o]);
          pn[0] += (gw - w) * (gw - w); pd[0] += w * w; pn[1] += (gkk - kk) * (gkk - kk); pd[1] += kk * kk; pn[2] += (gbv - kk * av) * (gbv - kk * av); pd[2] += kk * av * kk * av;
          pn[3] += (gkp - sh[3][lane]) * (gkp - sh[3][lane]); pd[3] += sh[3][lane] * sh[3][lane]; pn[4] += (grr - r) * (grr - r); pd[4] += r * r;
          sh2[0][lane] = gw; sh2[1][lane] = gkk; sh2[2][lane] = gbv; sh2[3][lane] = gkp; sh2[4][lane] = grr; }
        __syncthreads();
        float sa = 0.f;
#pragma unroll
        for (int j = 0; j < 64; ++j) sa -= S[j] * sh[1][j];
        float y = 0.f;
#pragma unroll
        for (int j = 0; j < 64; ++j) { S[j] = S[j] * sh[0][j] + sa * sh[2][j] + v * sh[3][j]; y += S[j] * sh[4][j]; }
        const float got = bf2f(Y[m * RW + c]), e = y - got;
        num += e * e; den += y * y;
        { float sa2 = 0.f;
#pragma unroll
          for (int j = 0; j < 64; ++j) sa2 -= S2[j] * sh2[1][j];
          float y2 = 0.f;
#pragma unroll
          for (int j = 0; j < 64; ++j) { S2[j] = S2[j] * sh2[0][j] + sa2 * sh2[2][j] + v * sh2[3][j]; y2 += S2[j] * sh2[4][j]; }
          num2 += (y2 - got) * (y2 - got); den2 += y2 * y2; }
        __syncthreads();
    }
    diag_acc(a.ws, 2, num, den);
#pragma unroll
    for (int q = 0; q < 5; ++q) diag_acc(a.ws, 12 + q, pn[q], pd[q]);
    diag_acc(a.ws, 17, num2, den2);
}
__global__ void __launch_bounds__(512) diag_mix(Args a, int l) {
    __shared__ float lg[128], la[64], red[16];
    const int m = blockIdx.x * 257 + 40, t = m % NT, c = threadIdx.x, lane = c & 63, wv = c >> 6;
    const bf16* PROJ = (const bf16*)(a.ws + WS_PROJ); const bf16* Y = (const bf16*)(a.ws + WS_HA); const bf16* MIX = (const bf16*)(a.ws + WS_HB);
    const bf16* p = PROJ + (size_t)m * NP;
    if (c < 128) lg[c] = 1.f / (1.f + expf(-(bf2f(p[C_PG + c]) + (t > 0 ? bf2f(p[C_QG + c - NP]) : 0.f))));
    else if (c < 192) la[c - 128] = bf2f(p[C_PA + c - 128]) + (t > 0 ? bf2f(p[C_QA + c - 128 - NP]) : 0.f);
    __syncthreads();
    float g = 0.f, ap = a.in[I_A0][l * RW + c];
    for (int j = 0; j < 128; ++j) g += lg[j] * a.in[I_G2][((size_t)l * 128 + j) * RW + c];
    for (int j = 0; j < 64; ++j) ap += la[j] * a.in[I_A2][((size_t)l * 64 + j) * RW + c];
    const float av = 1.f / (1.f + expf(-ap));
    const float mur = a.in[I_MURKV][l * 3 * RW + c], muk = a.in[I_MURKV][l * 3 * RW + RW + c], muv = a.in[I_MURKV][l * 3 * RW + 2 * RW + c];
    float r = bf2f(p[C_R + c]), k = bf2f(p[C_K + c]), v = bf2f(p[C_V + c]);
    if (t > 0) { r += (bf2f(p[C_R + c - NP]) - r) * mur; k += (bf2f(p[C_K + c - NP]) - k) * muk; v += (bf2f(p[C_V + c - NP]) - v) * muv; }
    else { r -= r * mur; k -= k * muk; v -= v * muv; }
    const float kp = k * (1.f + (av - 1.f) * a.in[I_KA][l * RW + c]);
    const float bon = wave_sum(r * kp * a.in[I_RK][l * RW + c]);
    const float y = bf2f(Y[(size_t)m * RW + c]);
    const float mean = wave_sum(y) * (1.f / 64.f), dd = y - mean, var = wave_sum(dd * dd) * (1.f / 64.f);
    const float ref = (dd * rsqrtf(var + GN_EPS) * a.in[I_LNXG][l * RW + c] + a.in[I_LNXB][l * RW + c] + bon * v) * g;
    const float got = bf2f(MIX[(size_t)m * DM + c]);
    diag_acc(a.ws, 3, (ref - got) * (ref - got), ref * ref);
    float n4 = 0.f, d4 = 0.f, n5 = 0.f, d5 = 0.f, cv = 0.f;
    if (c < 256) {
        float acc = 0.f;
        for (int kk = 0; kk < 3; ++kk) { const int tt = t - 2 + kk; if (tt >= 0) { const bf16* q = p - (size_t)(2 - kk) * NP; acc += a.in[I_SCW][(l * 3 + kk) * 256 + c] * bf2f(q[C_SCC + c]) * bf2f(q[C_SCU + c]); } }
        const float rs = bf2f(p[C_SCB + c]) * acc, gs = bf2f(MIX[(size_t)m * DM + 512 + c]);
        n4 = (rs - gs) * (rs - gs); d4 = rs * rs;
        cv = a.in[I_CFB][l * 256 + c];
        for (int kk = 0; kk < 31; ++kk) { const int tt = t - 30 + kk; if (tt >= 0) { const bf16* q = p - (size_t)(30 - kk) * NP; cv += a.in[I_CFW][((size_t)l * 31 + kk) * 256 + c] * bf2f(q[C_CFV + c]) / (1.f + expf(-bf2f(q[C_CFG + c]))); } }
    }
    diag_acc(a.ws, 4, n4, d4);
    float s = wave_sum(c < 256 ? cv : 0.f);
    if (lane == 0) red[wv] = s;
    __syncthreads();
    const float mean5 = (red[0] + red[1] + red[2] + red[3]) * (1.f / 256.f);
    const float dv = cv - mean5; s = wave_sum(c < 256 ? dv * dv : 0.f);
    if (lane == 0) red[8 + wv] = s;
    __syncthreads();
    const float var5 = (red[8] + red[9] + red[10] + red[11]) * (1.f / 256.f);
    if (c < 256) { float yy = dv * rsqrtf(var5 + LN_EPS) * a.in[I_CFLG][l * 256 + c] + a.in[I_CFLB][l * 256 + c]; yy = yy / (1.f + expf(-yy));
        const float gc = bf2f(MIX[(size_t)m * DM + 768 + c]); n5 = (yy - gc) * (yy - gc); d5 = yy * yy; }
    diag_acc(a.ws, 5, n5, d5);
}
__global__ void __launch_bounds__(512) diag_gemm_f32(Args a, size_t a_off, int K, int w_idx, size_t w_eloff, size_t tmp_off, int id) {
    __shared__ float arow[FF];
    const bf16* A = (const bf16*)(a.ws + a_off); const float* W = a.in[w_idx] + w_eloff; const float* TMP = (const float*)(a.ws + tmp_off);
    const int m = blockIdx.x * 257 + 7, tid = threadIdx.x;
    for (int k = tid; k < K; k += 512) arow[k] = bf2f(A[(size_t)m * K + k]);
    __syncthreads();
    float n = 0.f, d = 0.f;
    for (int c = tid; c < DM; c += 512) { float ref = 0.f; for (int k = 0; k < K; ++k) ref += arow[k] * W[(size_t)k * DM + c];
        const float e = ref - TMP[(size_t)m * DM + c]; n += e * e; d += ref * ref; }
    diag_acc(a.ws, id, n, d);
}
__global__ void __launch_bounds__(512) diag_norm(Args a, size_t tmp_off, int l, int id) {
    __shared__ float red[16];
    const float* TMP = (const float*)(a.ws + tmp_off); const float* xold = a.in[I_X]; const float* g1 = a.in[I_POSTMIX] + l * DM; const float* g2 = a.in[I_PREFFN] + l * DM;
    const int m = blockIdx.x * 257 + 7, tid = threadIdx.x, lane = tid & 63, wv = tid >> 6;
    const bf16* HA = (const bf16*)(a.ws + WS_HA);
    const float t0 = TMP[(size_t)m * DM + tid], t1 = TMP[(size_t)m * DM + 512 + tid];
    float s = wave_sum(t0 * t0 + t1 * t1); if (lane == 0) red[wv] = s; __syncthreads();
    float tot = 0.f; for (int i = 0; i < 8; ++i) tot += red[i];
    const float r = rsqrtf(tot * (1.f / DM) + NORM_EPS);
    const float x0 = xold[(size_t)m * DM + tid] + t0 * r * g1[tid], x1 = xold[(size_t)m * DM + 512 + tid] + t1 * r * g1[512 + tid];
    const float e0 = x0 - a.out[(size_t)m * DM + tid], e1 = x1 - a.out[(size_t)m * DM + 512 + tid];
    diag_acc(a.ws, id, e0 * e0 + e1 * e1, x0 * x0 + x1 * x1);
    s = wave_sum(x0 * x0 + x1 * x1); if (lane == 0) red[8 + wv] = s; __syncthreads();
    tot = 0.f; for (int i = 0; i < 8; ++i) tot += red[8 + i];
    const float r2 = rsqrtf(tot * (1.f / DM) + NORM_EPS);
    const float h0 = x0 * r2 * g2[tid], h1 = x1 * r2 * g2[512 + tid];
    const float f0 = h0 - bf2f(HA[(size_t)m * DM + tid]), f1 = h1 - bf2f(HA[(size_t)m * DM + 512 + tid]);
    diag_acc(a.ws, id + 1, f0 * f0 + f1 * f1, h0 * h0 + h1 * h1);
}
__global__ void __launch_bounds__(512) diag_swiglu(Args a, int l) {
    __shared__ float hrow[DM];
    const int m = blockIdx.x * 257 + 11, tid = threadIdx.x;
    const bf16* HA = (const bf16*)(a.ws + WS_HA); const bf16* Fb = (const bf16*)(a.ws + WS_PROJ);
    for (int k = tid; k < DM; k += 512) hrow[k] = bf2f(HA[(size_t)m * DM + k]);
    __syncthreads();
    float n = 0.f, d = 0.f;
    for (int c = tid; c < FF; c += 512) { float gg = 0.f, uu = 0.f; const float* Wg = a.in[I_WGATE] + (size_t)l * DM * FF + c; const float* Wu = a.in[I_WUP] + (size_t)l * DM * FF + c;
        for (int k = 0; k < DM; ++k) { gg += hrow[k] * Wg[(size_t)k * FF]; uu += hrow[k] * Wu[(size_t)k * FF]; }
        const float ref = gg / (1.f + expf(-gg)) * uu, e = ref - bf2f(Fb[(size_t)m * FF + c]); n += e * e; d += ref * ref; }
    diag_acc(a.ws, 11, n, d);
}
constexpr int DIAG_NID = 18;
__global__ void __launch_bounds__(256) diag_encode(Args a) {
    const float* D = (const float*)(a.ws + WS_CTL + 32768);
    int idx = 15; float dsel = 0.f;
    for (int q = 0; q < DIAG_NID; ++q) { const float d = D[2 * q] / fmaxf(D[2 * q + 1], 1e-30f); if (d > dsel) dsel = d; }
    for (int qq = 0; qq < DIAG_NID; ++qq) { const int q = qq < 6 ? 12 + qq : qq - 6; const float d = D[2 * q] / fmaxf(D[2 * q + 1], 1e-30f); if (!(d < 1e-3f)) { idx = qq; dsel = d; break; } }
    const float c = 3000.f * sqrtf(dsel);
    for (size_t i = (size_t)blockIdx.x * 256 + threadIdx.x; i < (size_t)M * DM; i += (size_t)gridDim.x * 256) a.out[i] = c;
    if (blockIdx.x == 0 && threadIdx.x == 0) a.out[0] = c * powf(1.6f, (float)(idx + 6));
}
#endif
#ifndef PH_MASK
#define PH_MASK 0x3ff
#endif
#define PH_ON(k) (((PH_MASK) >> (k)) & 1)
#ifndef PH_TWICE
#define PH_TWICE 0
#endif
constexpr int PH_PER_LAYER = 10, N_PHASES = NL * PH_PER_LAYER;
__global__ void __launch_bounds__(NTHR, 2) fwd(Args args) {
    extern __shared__ __attribute__((aligned(16))) unsigned char lds_raw[];
    Frame F;
    F.lds = (LAS unsigned char*)lds_raw;
    F.tid = threadIdx.x; F.lane = F.tid & 63; F.wave = __builtin_amdgcn_readfirstlane(F.tid >> 6);
    F.blk = blockIdx.x; F.G = gridDim.x; F.in = args.in; F.out = args.out; F.ws = args.ws;
    volatile LAS unsigned* MISC = (volatile LAS unsigned*)(F.lds + MISC_OFF);
    if (F.tid < 32) MISC[F.tid] = 0u;
    __syncthreads();
    XcdBarrier bar; bar.bar = (unsigned*)(F.ws + WS_CTL) + 4096; bar.x = 0; bar.st = nullptr;
    const bool multi = (args.ph_hi - args.ph_lo) > 1;
    if (multi) bar = xcd_barrier_post((unsigned*)(F.ws + WS_CTL) + 4096, MISC + 8);
    bf16* WIN = (bf16*)(F.ws + WS_WIN); bf16* WO = (bf16*)(F.ws + WS_WO); bf16* WGU = (bf16*)(F.ws + WS_WGU); bf16* WDN = (bf16*)(F.ws + WS_WDN);
    bf16* HA = (bf16*)(F.ws + WS_HA); bf16* HB = (bf16*)(F.ws + WS_HB); bf16* PROJ = (bf16*)(F.ws + WS_PROJ);
    float* TMP1 = (float*)(F.ws + WS_PROJ); float* TMP2 = (float*)(F.ws + WS_X1);
    for (int ph = args.ph_lo; ph < args.ph_hi; ++ph) {
        const int l = ph / PH_PER_LAYER, k = ph % PH_PER_LAYER;
        for (int rep = 0; rep < (((PH_TWICE) >> k) & 1) + 1; ++rep) {
        if (rep) __syncthreads();
        { int t_ = threadIdx.x; asm volatile("" : "+v"(t_)); F.tid = t_; F.lane = t_ & 63; F.wave = __builtin_amdgcn_readfirstlane(t_ >> 6); }
        switch (k) {
        case 0: if (PH_ON(0)) { phase_conv(F, l); if (l == 0) phase_norm0(F); } break;
        case 1: if (PH_ON(1)) { pg8::Gemm g{HA, WIN, M, NP, DM}; pg8::StaticOrder S; S.init(M, NP, F.G, F.blk); pg8::EpiBf16 E{PROJ, NP};
                  pg8::gemm_phase<pg8::EpiBf16, pg8::StaticOrder, true, true>(F.lds, g, S, E); } break;
        case 2: if (PH_ON(2)) { phase_prep2(F, l); __syncthreads(); phase_sc2(F, l); phase_cf2(F, l); } break;
        case 3: if (PH_ON(3)) phase_scan2(F, l); break;
        case 4: if (PH_ON(4)) phase_post2(F, l); break;
        case 5: if (PH_ON(5)) { pg8::Gemm g{HB, WO, M, DM, DM}; pg8::StaticOrder S; S.init(M, DM, F.G, F.blk); pg8::EpiF32 E{TMP1, DM};
                  pg8::gemm_phase<pg8::EpiF32, pg8::StaticOrder, true, true>(F.lds, g, S, E); } break;
        case 6: if (PH_ON(6)) phase_norm_res(F, TMP1, l == 0 ? F.in[I_X] : F.out, F.in[I_POSTMIX] + l * DM, F.in[I_PREFFN] + l * DM); break;
        case 7: if (PH_ON(7)) { pg8::Gemm g{HA, WGU, M, NGU, DM}; pg8::StaticOrder S; S.init(M, NGU, F.G, F.blk); pg8::EpiSwiGLU E{PROJ, FF};
                  pg8::gemm_phase<pg8::EpiSwiGLU, pg8::StaticOrder, true, true>(F.lds, g, S, E); } break;
        case 8: if (PH_ON(8)) { pg8::Gemm g{PROJ, WDN, M, DM, FF}; pg8::StaticOrder S; S.init(M, DM, F.G, F.blk); pg8::EpiF32 E{TMP2, DM};
                  pg8::gemm_phase<pg8::EpiF32, pg8::StaticOrder, true, true>(F.lds, g, S, E); } break;
        case 9: if (PH_ON(9)) phase_norm_res(F, TMP2, F.out, F.in[I_POSTFFN] + l * DM, l + 1 < NL ? F.in[I_PREMIX] + (l + 1) * DM : nullptr); break;
        }
        }
        if (ph + 1 < args.ph_hi) xcd_barrier(bar);
    }
}

#ifndef MK_ONE_LAUNCH
#define MK_ONE_LAUNCH 1
#endif
extern "C" void kernel_launch(void* const* d_in, const int* in_sizes, int n_in, void* d_out, int out_size, void* d_ws, size_t ws_size, hipStream_t stream) {
    static int grid = 0;
    if (grid == 0) {
        if (n_in != N_IN || in_sizes[0] != M * DM || out_size != M * DM || ws_size < WS_END) { fprintf(stderr, "kernel_launch: unexpected shapes (n_in %d, ws %zu)\n", n_in, ws_size); grid = -1; return; }
        int dev = 0, cus = 0, per_cu = 0;
        if (hipGetDevice(&dev) != hipSuccess || hipDeviceGetAttribute(&cus, hipDeviceAttributeMultiprocessorCount, dev) != hipSuccess) { grid = -1; return; }
        if (hipFuncSetAttribute((const void*)fwd, hipFuncAttributeMaxDynamicSharedMemorySize, LDS_BYTES) != hipSuccess) { fprintf(stderr, "kernel_launch: hipFuncSetAttribute failed\n"); grid = -1; return; }
        if (hipOccupancyMaxActiveBlocksPerMultiprocessor(&per_cu, (const void*)fwd, NTHR, LDS_BYTES) != hipSuccess || per_cu < 1) { fprintf(stderr, "kernel_launch: occupancy query says %d blocks per CU\n", per_cu); grid = -1; (void)hipGetLastError(); return; }
        grid = cus;
    }
    if (grid < 0) return;
    (void)hipMemsetAsync((char*)d_ws + WS_CTL, 0, CTL_ZERO_BYTES, stream);
    Args a{};
    for (int i = 0; i < N_IN; ++i) a.in[i] = (const float*)d_in[i];
    a.out = (float*)d_out; a.ws = (unsigned char*)d_ws;
#if MK_ONE_LAUNCH
    a.ph_lo = 0; a.ph_hi = N_PHASES;
    hipLaunchKernelGGL(fwd, dim3(grid), dim3(NTHR), LDS_BYTES, stream, a);
#else
    for (int ph = 0; ph < N_PHASES; ++ph) { a.ph_lo = ph; a.ph_hi = ph + 1; hipLaunchKernelGGL(fwd, dim3(grid), dim3(NTHR), LDS_BYTES, stream, a);
#if DIAG
        const int l = ph / PH_PER_LAYER, k = ph % PH_PER_LAYER;
        if (l == DIAG_L) {
            if (k == 1) hipLaunchKernelGGL(diag_proj, dim3(64), dim3(512), 0, stream, a, l);
            if (k == 3) hipLaunchKernelGGL(diag_y, dim3(8), dim3(64), 0, stream, a, l);
            if (k == 4) hipLaunchKernelGGL(diag_mix, dim3(63), dim3(512), 0, stream, a, l);
            if (k == 5) hipLaunchKernelGGL(diag_gemm_f32, dim3(63), dim3(512), 0, stream, a, (size_t)WS_HB, (int)DM, (int)I_WO, (size_t)l * DM * DM, (size_t)WS_PROJ, 6);
            if (k == 6 && l == 0) hipLaunchKernelGGL(diag_norm, dim3(63), dim3(512), 0, stream, a, (size_t)WS_PROJ, l, 7);
            if (k == 7) hipLaunchKernelGGL(diag_swiglu, dim3(63), dim3(512), 0, stream, a, l);
            if (k == 8) hipLaunchKernelGGL(diag_gemm_f32, dim3(63), dim3(512), 0, stream, a, (size_t)WS_PROJ, (int)FF, (int)I_WDOWN, (size_t)l * FF * DM, (size_t)WS_X1, 9);
        }
#endif
    }
#if DIAG
    hipLaunchKernelGGL(diag_encode, dim3(1024), dim3(256), 0, stream, a);
#endif
#endif
}
```

```cpp
#include <hip/hip_runtime.h>
#include <type_traits>
#include <cstdio>
#include <cstdint>
namespace pg8 {
#define PG8_LAS __attribute__((address_space(3)))
#define PG8_GAS __attribute__((address_space(1)))
typedef unsigned short bf16_t;
typedef short bf16x8 __attribute__((ext_vector_type(8)));
typedef float f32x4 __attribute__((ext_vector_type(4)));
typedef unsigned u32x4 __attribute__((ext_vector_type(4)));
constexpr int BM = 256, BK = 64, HALF = 128, HTB = HALF * BK * 2  , STAGE_BYTES = 8 * HTB, NXCD = 8, WGM = 8;

__host__ __device__ __forceinline__ int lds_byte(int r, int c) { const int st = (r >> 4) * 2 + (c >> 5), rr = r & 15, cc = c & 31, ob = rr * 64 + cc * 2; return st * 1024 + (ob ^ (((ob >> 9) & 1) << 5)); }
__host__ __device__ __forceinline__ void stage_rc(int b, int& R, int& C) { const int st = b / 1024, sb = b % 1024, swz = sb ^ (((sb >> 9) & 1) << 5); R = (st >> 1) * 16 + swz / 64; C = (st & 1) * 32 + (swz % 64) / 2; }
__host__ __device__ __forceinline__ int perm32(int rho) { const int n = rho >> 4, i = rho & 15; return 8 * (i >> 2) + 4 * n + (i & 3); }

struct Unit { int pm, pn; };
struct Gemm { const bf16_t* A; const bf16_t* Bt; int M, N, K; int lda; };

struct StaticOrder {
    int nM, nN, nwg, G, c, pn_from, pn_to;
    __host__ __device__ void init(int M, int N, int G_, int c_) { nM = M / BM; nN = N / BM; nwg = nM * nN; G = G_; c = c_; pn_from = -1; pn_to = -1; }
    __host__ __device__ bool next(int i, Unit& u) const {
        const long L = (long)i * G + c; if (L >= nwg) return false;
        int wgid = (int)L; { const int q = nwg / NXCD, r = nwg % NXCD, xcd = wgid % NXCD, off = wgid / NXCD; wgid = (xcd < r ? xcd * (q + 1) : r * (q + 1) + (xcd - r) * q) + off; }
        const int nig = WGM * nN, gid = wgid / nig, fm = gid * WGM, gsz = (nM - fm) < WGM ? (nM - fm) : WGM;
        u.pm = fm + ((wgid % nig) % gsz); u.pn = (wgid % nig) / gsz; if (u.pn == pn_from) u.pn = pn_to; return true;
    }
    __device__ __forceinline__ void a_ready(const Unit&) const {}
    __device__ __forceinline__ void done(const Unit&) const {}
};

struct OneUnit { int pm, pn;
    __device__ __forceinline__ bool next(int i, Unit& u) const { if (i != 0) return false; u.pm = pm; u.pn = pn; return true; }
    __device__ __forceinline__ void a_ready(const Unit&) const {}
    __device__ __forceinline__ void done(const Unit&) const {}
};
__device__ __forceinline__ unsigned cvt_pk_bf16(float lo, float hi) { unsigned r; asm volatile("v_cvt_pk_bf16_f32 %0, %1, %2" : "=v"(r) : "v"(lo), "v"(hi)); return r; }
typedef float f32x2 __attribute__((ext_vector_type(2)));
struct EpiBf16 {
    static constexpr bool PERM = true, AFTER_DRAIN = false;
    bf16_t* O; int ldc;
    __device__ __forceinline__ void operator()(const f32x4 (&acc)[2][2][4][2], const Unit& u, int wr, int wc, int fr, int fq) const {
        const int row0 = u.pm * BM + wr * 64 + fr, col0 = u.pn * BM + wc * 32 + 8 * fq;
#pragma unroll
        for (int ai = 0; ai < 2; ++ai)
#pragma unroll
            for (int m = 0; m < 4; ++m) { bf16_t* rowp = O + (size_t)(row0 + ai * HALF + m * 16) * ldc + col0;
#pragma unroll
                for (int bj = 0; bj < 2; ++bj) { const f32x4 v0 = acc[ai][bj][m][0], v1 = acc[ai][bj][m][1];
                    u32x4 w; w.x = cvt_pk_bf16(v0[0], v0[1]); w.y = cvt_pk_bf16(v0[2], v0[3]); w.z = cvt_pk_bf16(v1[0], v1[1]); w.w = cvt_pk_bf16(v1[2], v1[3]);
                    *(PG8_GAS u32x4*)(rowp + bj * HALF) = w; } }
    }
};
struct EpiF32 {
    static constexpr bool PERM = false, AFTER_DRAIN = false;
    float* C; int ldc;
    __device__ __forceinline__ void operator()(const f32x4 (&acc)[2][2][4][2], const Unit& u, int wr, int wc, int fr, int fq) const {
        const int row0 = u.pm * BM + wr * 64 + fr, col0 = u.pn * BM + wc * 32 + 4 * fq;
#pragma unroll
        for (int ai = 0; ai < 2; ++ai)
#pragma unroll
            for (int m = 0; m < 4; ++m) { float* rowp = C + (size_t)(row0 + ai * HALF + m * 16) * ldc + col0;
#pragma unroll
                for (int bj = 0; bj < 2; ++bj)
#pragma unroll
                    for (int n = 0; n < 2; ++n) *(PG8_GAS f32x4*)(rowp + bj * HALF + n * 16) = acc[ai][bj][m][n]; }
    }
};
struct EpiSide {
    static constexpr bool PERM = true, AFTER_DRAIN = false;
    bf16_t* O; int ldc; int mode, ocol;
    __device__ __forceinline__ void operator()(const f32x4 (&acc)[2][2][4][2], const Unit& u, int wr, int wc, int fr, int fq) const {
        const int row0 = u.pm * BM + wr * 64 + fr;
        if (mode == 0) {
            const int col0 = u.pn * BM + wc * 32 + 8 * fq;
#pragma unroll
            for (int ai = 0; ai < 2; ++ai)
#pragma unroll
                for (int m = 0; m < 4; ++m) { bf16_t* rowp = O + (size_t)(row0 + ai * HALF + m * 16) * ldc + col0;
#pragma unroll
                    for (int bj = 0; bj < 2; ++bj) { const f32x4 v0 = acc[ai][bj][m][0], v1 = acc[ai][bj][m][1];
                        u32x4 w; w.x = cvt_pk_bf16(v0[0], v0[1]); w.y = cvt_pk_bf16(v0[2], v0[3]); w.z = cvt_pk_bf16(v1[0], v1[1]); w.w = cvt_pk_bf16(v1[2], v1[3]);
                        *(PG8_GAS u32x4*)(rowp + bj * HALF) = w; } }
            return;
        }
        const int col0 = ocol + wc * 32 + 8 * fq;
#pragma unroll
        for (int ai = 0; ai < 2; ++ai)
#pragma unroll
            for (int m = 0; m < 4; ++m) { bf16_t* rowp = O + (size_t)(row0 + ai * HALF + m * 16) * ldc + col0;
                float o[8];
#pragma unroll
                for (int n = 0; n < 2; ++n)
#pragma unroll
                    for (int e = 0; e < 4; ++e) { const float a = acc[ai][0][m][n][e], b = acc[ai][1][m][n][e];
                        o[n * 4 + e] = mode == 1 ? a * b : a * __builtin_amdgcn_rcpf(1.0f + __builtin_amdgcn_exp2f(-1.44269504089f * b)); }
                u32x4 w; w.x = cvt_pk_bf16(o[0], o[1]); w.y = cvt_pk_bf16(o[2], o[3]); w.z = cvt_pk_bf16(o[4], o[5]); w.w = cvt_pk_bf16(o[6], o[7]);
                *(PG8_GAS u32x4*)rowp = w; }
    }
};
struct EpiSwiGLU {
    static constexpr bool PERM = true, AFTER_DRAIN = false;
    bf16_t* O; int ldc;
    __device__ __forceinline__ void operator()(const f32x4 (&acc)[2][2][4][2], const Unit& u, int wr, int wc, int fr, int fq) const {
        const int row0 = u.pm * BM + wr * 64 + fr, col0 = u.pn * HALF + wc * 32 + 8 * fq;
#pragma unroll
        for (int ai = 0; ai < 2; ++ai)
#pragma unroll
            for (int m = 0; m < 4; ++m) { bf16_t* rowp = O + (size_t)(row0 + ai * HALF + m * 16) * ldc + col0;
                float o[8];
#pragma unroll
                for (int n = 0; n < 2; ++n)
#pragma unroll
                    for (int e = 0; e < 4; ++e) { const float g = acc[ai][0][m][n][e], up = acc[ai][1][m][n][e];
                        o[n * 4 + e] = g * __builtin_amdgcn_rcpf(1.0f + __builtin_amdgcn_exp2f(-1.44269504089f * g)) * up; }
                u32x4 w; w.x = cvt_pk_bf16(o[0], o[1]); w.y = cvt_pk_bf16(o[2], o[3]); w.z = cvt_pk_bf16(o[4], o[5]); w.w = cvt_pk_bf16(o[6], o[7]);
                *(PG8_GAS u32x4*)rowp = w; }
    }
};


__device__ __forceinline__ float xsum16(float s) { const unsigned u = __float_as_uint(s); const auto r = __builtin_amdgcn_permlane16_swap(u, u, false, false); return __uint_as_float(r[0]) + __uint_as_float(r[1]); }
__device__ __forceinline__ float xsum32(float s) { const unsigned u = __float_as_uint(s); const auto r = __builtin_amdgcn_permlane32_swap(u, u, false, false); return __uint_as_float(r[0]) + __uint_as_float(r[1]); }
struct PanelSS {
    unsigned* xbuf;
    unsigned tag;
    unsigned* tmo;
    unsigned code;
    __device__ __forceinline__ void publish(const f32x4 (&v)[2][2][4][2], const Unit& u, int wr, int wc, int fr, int fq, PG8_LAS unsigned char* lds, int wid, int lane) const {
        PG8_LAS float* P = (PG8_LAS float*)lds;
        PG8_LAS unsigned* flag = (PG8_LAS unsigned*)(lds + 8192 + 2048);
#pragma unroll
        for (int ai = 0; ai < 2; ++ai)
#pragma unroll
            for (int m = 0; m < 4; ++m) {
                float s = 0.f;
#pragma unroll
                for (int bj = 0; bj < 2; ++bj)
#pragma unroll
                    for (int n = 0; n < 2; ++n) { const f32x4 x = v[ai][bj][m][n]; s += (x[0] * x[0] + x[1] * x[1]) + (x[2] * x[2] + x[3] * x[3]); }
                s = xsum16(s); s = xsum32(s);
                if (fq == 0) P[(ai * HALF + wr * 64 + m * 16 + fr) * 4 + wc] = s;
            }
        if (wid == 0 && lane == 0) flag[0] = 0u;
        asm volatile("s_waitcnt lgkmcnt(0)" ::: "memory"); __builtin_amdgcn_s_barrier(); asm volatile("" ::: "memory");
        const int row = wid * 32 + (lane & 31);
        if (lane < 32) {
            const float tot = (P[row * 4 + 0] + P[row * 4 + 1]) + (P[row * 4 + 2] + P[row * 4 + 3]);
            __hip_atomic_store((PG8_GAS unsigned*)xbuf + (size_t)(u.pm * BM + row) * 4 + u.pn, (__float_as_uint(tot) & ~15u) | tag, __ATOMIC_RELAXED, __HIP_MEMORY_SCOPE_AGENT);
        }
    }
    __device__ __forceinline__ bool collect(const Unit& u, PG8_LAS unsigned char* lds, int wid, int lane) const {
        PG8_LAS float* S = (PG8_LAS float*)(lds + 8192);
        PG8_LAS unsigned* flag = (PG8_LAS unsigned*)(lds + 8192 + 2048);
        const int row = wid * 32 + (lane & 31);
        if (lane < 32) {
            PG8_GAS unsigned* slot = (PG8_GAS unsigned*)xbuf + (size_t)(u.pm * BM + row) * 4; bool dead = false; unsigned w0, w1, w2, w3, sp = 0u;
            if (lane == 0) {
                for (unsigned s0 = 0u; s0 < (1u << 16); ++s0) {
                    const unsigned a0 = __hip_atomic_load(slot + 0, __ATOMIC_RELAXED, __HIP_MEMORY_SCOPE_AGENT), a1 = __hip_atomic_load(slot + 1, __ATOMIC_RELAXED, __HIP_MEMORY_SCOPE_AGENT),
                                   a2 = __hip_atomic_load(slot + 2, __ATOMIC_RELAXED, __HIP_MEMORY_SCOPE_AGENT), a3 = __hip_atomic_load(slot + 3, __ATOMIC_RELAXED, __HIP_MEMORY_SCOPE_AGENT);
                    if ((((a0 ^ tag) | (a1 ^ tag) | (a2 ^ tag) | (a3 ^ tag)) & 15u) == 0u) break;
                    __builtin_amdgcn_s_sleep(2); } }
            for (;;) {
                w0 = __hip_atomic_load(slot + 0, __ATOMIC_RELAXED, __HIP_MEMORY_SCOPE_AGENT); w1 = __hip_atomic_load(slot + 1, __ATOMIC_RELAXED, __HIP_MEMORY_SCOPE_AGENT);
                w2 = __hip_atomic_load(slot + 2, __ATOMIC_RELAXED, __HIP_MEMORY_SCOPE_AGENT); w3 = __hip_atomic_load(slot + 3, __ATOMIC_RELAXED, __HIP_MEMORY_SCOPE_AGENT);
                if ((((w0 ^ tag) | (w1 ^ tag) | (w2 ^ tag) | (w3 ^ tag)) & 15u) == 0u) break;
                if (++sp > (1u << 17)) { dead = true; break; }
                __builtin_amdgcn_s_sleep(1); }
            const float ss = (__uint_as_float(w0 & ~15u) + __uint_as_float(w1 & ~15u)) + (__uint_as_float(w2 & ~15u) + __uint_as_float(w3 & ~15u));
            S[row] = ss;
            if (dead) { flag[0] = 1u; unsigned expect = 0u; __hip_atomic_compare_exchange_strong(tmo + 1, &expect, code | (unsigned)(u.pm & 0xff), __ATOMIC_RELAXED, __ATOMIC_RELAXED, __HIP_MEMORY_SCOPE_AGENT);
                        __hip_atomic_store(tmo, 1u, __ATOMIC_RELAXED, __HIP_MEMORY_SCOPE_AGENT); }
        }
        asm volatile("s_waitcnt vmcnt(0) lgkmcnt(0)" ::: "memory"); __builtin_amdgcn_s_barrier(); asm volatile("" ::: "memory");
        return flag[0] != 0u;
    }
};
struct EpiRmsRes2 {
    static constexpr bool PERM = true, AFTER_DRAIN = true;
    const float* base; float* out; const float* g1; const unsigned* bstat; PanelSS st1, st2; float eps; int last;
    __device__ __forceinline__ void fused(f32x4 (&acc)[2][2][4][2], const Unit& u, int wr, int wc, int fr, int fq, PG8_LAS unsigned char* lds, int wid, int lane) const {
        typedef unsigned u32x2v __attribute__((ext_vector_type(2)));
        const PG8_LAS float* S = (const PG8_LAS float*)(lds + 8192); PG8_LAS float* SB = (PG8_LAS float*)(lds + 8192 + 4096);
        const int col0 = u.pn * BM + wc * 32 + 8 * fq; constexpr int ldc = 1024;
        f32x4 gg1[2][2]; u32x4 rb[3][2];
        const bf16_t* baseh = (const bf16_t*)base; bf16_t* outh = (bf16_t*)out;
#pragma unroll
        for (int bj = 0; bj < 2; ++bj)
#pragma unroll
            for (int n = 0; n < 2; ++n) gg1[bj][n] = *(const PG8_GAS f32x4*)(g1 + col0 + bj * HALF + n * 4);
        st1.publish(acc, u, wr, wc, fr, fq, lds, wid, lane);
#pragma unroll
        for (int gi = 0; gi < 2; ++gi) { const size_t off = (size_t)(u.pm * BM + wr * 64 + gi * 16 + fr) * ldc + col0;
#pragma unroll
            for (int bj = 0; bj < 2; ++bj) rb[gi][bj] = *(const PG8_GAS u32x4*)(baseh + off + bj * HALF); }
        if (lane < 32) { const int row = wid * 32 + lane; const u32x4 w = *(const PG8_GAS u32x4*)(bstat + (size_t)(u.pm * BM + row) * 4);
            const float ss = (__uint_as_float(w.x & ~15u) + __uint_as_float(w.y & ~15u)) + (__uint_as_float(w.z & ~15u) + __uint_as_float(w.w & ~15u));
            SB[row] = __builtin_amdgcn_sqrtf(ss * (1.0f / 1024.0f) + eps); }
        bool bad = st1.collect(u, lds, wid, lane);
        const float qnan = __builtin_nanf("");
#pragma unroll
        for (int gi = 0; gi < 8; ++gi) { const int ai = gi >> 2, m = gi & 3;
            if (gi + 2 < 8) { const int g2i = gi + 2; const size_t off = (size_t)(u.pm * BM + (g2i >> 2) * HALF + wr * 64 + (g2i & 3) * 16 + fr) * ldc + col0;
#pragma unroll
                for (int bj = 0; bj < 2; ++bj) rb[g2i % 3][bj] = *(const PG8_GAS u32x4*)(baseh + off + bj * HALF); }
            const int r = ai * HALF + wr * 64 + m * 16 + fr; const float r1 = __builtin_amdgcn_rsqf(S[r] * (1.0f / 1024.0f) + eps), sb = SB[r];
#pragma unroll
            for (int bj = 0; bj < 2; ++bj)
#pragma unroll
                for (int n = 0; n < 2; ++n) { const u32x4 w4 = rb[gi % 3][bj]; const unsigned wx = n ? w4.z : w4.x, wy = n ? w4.w : w4.y;
                    const f32x4 bs = (f32x4){__uint_as_float(wx << 16), __uint_as_float(wx & 0xffff0000u), __uint_as_float(wy << 16), __uint_as_float(wy & 0xffff0000u)};
                    acc[ai][bj][m][n] = bs * sb + acc[ai][bj][m][n] * r1 * gg1[bj][n]; }
            asm volatile("" ::: "memory"); }
        if (last) {
#pragma unroll
            for (int ai = 0; ai < 2; ++ai)
#pragma unroll
                for (int m = 0; m < 4; ++m) { int r = ai * HALF + wr * 64 + m * 16 + fr; asm volatile("" : "+v"(r));     const size_t off = (size_t)(u.pm * BM + r) * ldc + col0;
#pragma unroll
                    for (int bj = 0; bj < 2; ++bj)
#pragma unroll
                        for (int n = 0; n < 2; ++n) *(PG8_GAS f32x4*)(out + off + bj * HALF + n * 4) = bad ? (f32x4){qnan, qnan, qnan, qnan} : acc[ai][bj][m][n]; }
            return;
        }
        st2.publish(acc, u, wr, wc, fr, fq, lds, wid, lane);
        bad = st2.collect(u, lds, wid, lane) || bad;
#pragma unroll
        for (int ai = 0; ai < 2; ++ai)
#pragma unroll
            for (int m = 0; m < 4; ++m) { int r = ai * HALF + wr * 64 + m * 16 + fr; asm volatile("" : "+v"(r)); const float r2 = __builtin_amdgcn_rsqf(S[r] * (1.0f / 1024.0f) + eps); const size_t off = (size_t)(u.pm * BM + r) * ldc + col0;
#pragma unroll
                for (int bj = 0; bj < 2; ++bj) { const f32x4 xa = acc[ai][bj][m][0] * r2, xb = acc[ai][bj][m][1] * r2; u32x4 w;
                    w.x = cvt_pk_bf16(xa[0], xa[1]); w.y = cvt_pk_bf16(xa[2], xa[3]); w.z = cvt_pk_bf16(xb[0], xb[1]); w.w = cvt_pk_bf16(xb[2], xb[3]);
                    if (bad) w = (u32x4){0x7fc07fc0u, 0x7fc07fc0u, 0x7fc07fc0u, 0x7fc07fc0u};
                    *(PG8_GAS u32x4*)(outh + off + bj * HALF) = w; }
                asm volatile("" ::: "memory"); }
    }
};

template <class Epi, class Sched, bool ALIGN_EPI = false, bool SP2 = false>
__device__ __forceinline__ void gemm_phase(PG8_LAS unsigned char* lds, const Gemm g, const Sched& S, const Epi& E) {
    int tid_l = threadIdx.x; asm volatile("" : "+v"(tid_l));
    const int tid = tid_l, wid = __builtin_amdgcn_readfirstlane(tid >> 6), lane = tid & 63, wr = wid >> 2, wc = wid & 3, fr = lane & 15, fq = lane >> 4;
    const int K = g.K, nt = K / BK, LDA = g.lda ? g.lda : g.K;
    unsigned voffA[2], voffB[2];
#pragma unroll
    for (int i = 0; i < 2; ++i) { int R, C; stage_rc(tid * 16 + i * 8192, R, C); const int Rb = Epi::PERM ? ((R & ~31) + perm32(R & 31)) : R;
        voffA[i] = (unsigned)(R * LDA + C) * 2u; voffB[i] = (unsigned)(Rb * K + C) * 2u; }
    const size_t kstep = (size_t)(BK * 2);
    const size_t hstep = (size_t)HALF * K * 2;
    const size_t tstep = 2 * hstep;
    const size_t hstepA = (size_t)HALF * LDA * 2, tstepA = 2 * hstepA;
    const unsigned ldsw = (unsigned)wid * 1024u;
    const int aoff = lds_byte(wr * 64 + fr, fq * 8), boff = lds_byte(wc * 32 + fr, fq * 8);
#define PG8_SA(b, h) (((b) * 2 + (h)) * HTB)
#define PG8_SB(b, h) ((4 + (b) * 2 + (h)) * HTB)
#define PG8_STAGE(bufoff, gbase, voff) do { _Pragma("unroll") for (int _i = 0; _i < 2; ++_i) \
        __builtin_amdgcn_global_load_lds((const unsigned*)((const char*)(gbase) + (voff)[_i]), (PG8_LAS unsigned*)(lds + (bufoff) + ldsw + _i * 8192), 16, 0, 0); } while (0)
#define PG8_LDA(dst, b, h) do { _Pragma("unroll") for (int m = 0; m < 4; ++m) _Pragma("unroll") for (int k = 0; k < 2; ++k) dst[m][k] = *(const PG8_LAS bf16x8*)(lds + PG8_SA(b, h) + aoff + m * 2048 + k * 1024); } while (0)
#define PG8_LDB(dst, b, h) do { _Pragma("unroll") for (int n = 0; n < 2; ++n) _Pragma("unroll") for (int k = 0; k < 2; ++k) dst[n][k] = *(const PG8_LAS bf16x8*)(lds + PG8_SB(b, h) + boff + n * 2048 + k * 1024); } while (0)
#define PG8_MMA(ai, bj, At, Bt) do { __builtin_amdgcn_s_setprio(1); _Pragma("unroll") for (int m = 0; m < 4; ++m) _Pragma("unroll") for (int n = 0; n < 2; ++n) _Pragma("unroll") for (int k = 0; k < 2; ++k) \
        acc[ai][bj][m][n] = __builtin_amdgcn_mfma_f32_16x16x32_bf16(Bt[n][k], At[m][k], acc[ai][bj][m][n], 0, 0, 0); __builtin_amdgcn_s_setprio(0); } while (0)
#define PG8_WAIT_V(n) asm volatile("s_waitcnt vmcnt(" #n ")" ::: "memory")
#define PG8_WAIT_L(n) asm volatile("s_waitcnt lgkmcnt(" #n ")" ::: "memory")
#define PG8_BAR __builtin_amdgcn_s_barrier()
#define PG8_SCHED __builtin_amdgcn_sched_barrier(0)
    Unit cur, nxt; int ui = 0;
    if (!S.next(0, cur)) return;
    f32x4 acc[2][2][4][2];
#pragma unroll
    for (int a = 0; a < 2; ++a)
#pragma unroll
        for (int b = 0; b < 2; ++b)
#pragma unroll
            for (int m = 0; m < 4; ++m)
#pragma unroll
                for (int n = 0; n < 2; ++n) acc[a][b][m][n] = (f32x4){0.f, 0.f, 0.f, 0.f};
    bf16x8 At[4][2], B0[2][2], B1[2][2];
    const char* cA = (const char*)g.A + (size_t)cur.pm * tstepA; const char* cB = (const char*)g.Bt + (size_t)cur.pn * tstep;
    S.a_ready(cur);
    if constexpr (SP2) {
        PG8_STAGE(PG8_SB(0, 0), cB, voffB); PG8_STAGE(PG8_SB(0, 1), cB + hstep, voffB); PG8_STAGE(PG8_SA(0, 0), cA, voffA); PG8_STAGE(PG8_SA(0, 1), cA + hstepA, voffA);
        if (wr == 1) PG8_BAR;
        PG8_WAIT_V(2); PG8_BAR;
        PG8_STAGE(PG8_SB(1, 0), cB + kstep, voffB); PG8_STAGE(PG8_SA(1, 0), cA + kstep, voffA); PG8_STAGE(PG8_SB(1, 1), cB + hstep + kstep, voffB);
        PG8_WAIT_V(6); PG8_BAR;
    } else {
        PG8_STAGE(PG8_SB(0, 0), cB, voffB); PG8_STAGE(PG8_SA(0, 0), cA, voffA); PG8_STAGE(PG8_SB(0, 1), cB + hstep, voffB); PG8_STAGE(PG8_SA(0, 1), cA + hstepA, voffA);
        if (wr == 1) PG8_BAR;
        PG8_WAIT_V(4); PG8_BAR;
        PG8_STAGE(PG8_SB(1, 0), cB + kstep, voffB); PG8_STAGE(PG8_SA(1, 0), cA + kstep, voffA); PG8_STAGE(PG8_SB(1, 1), cB + hstep + kstep, voffB);
        PG8_WAIT_V(6); PG8_BAR;
    }
    for (;;) {
        const bool has_next = S.next(ui + 1, nxt);
        const char* nA = has_next ? (const char*)g.A + (size_t)nxt.pm * tstepA : cA; const char* nB = has_next ? (const char*)g.Bt + (size_t)nxt.pn * tstep : cB;
        for (int t = 0; t < nt; t += 2) {
            const bool last = (t == nt - 2);
            const char* a1 = cA + (size_t)(t + 1) * kstep;
            const char* a2 = last ? nA : cA + (size_t)(t + 2) * kstep; const char* b2 = last ? nB : cB + (size_t)(t + 2) * kstep;
            const char* a3 = a2 + kstep; const char* b3 = b2 + kstep;
            if (last && has_next) S.a_ready(nxt);
            if constexpr (SP2) {
            PG8_LDB(B0, 0, 0); PG8_LDB(B1, 0, 1); PG8_SCHED; PG8_LDA(At, 0, 0); PG8_STAGE(PG8_SA(1, 1), a1 + hstepA, voffA);
            PG8_WAIT_V(8); PG8_WAIT_L(0); PG8_BAR; PG8_MMA(0, 0, At, B0); PG8_MMA(0, 1, At, B1); PG8_BAR; PG8_SCHED;
            PG8_LDA(At, 0, 1); PG8_STAGE(PG8_SB(0, 0), b2, voffB); PG8_STAGE(PG8_SB(0, 1), b2 + hstep, voffB); PG8_STAGE(PG8_SA(0, 0), a2, voffA);
            PG8_WAIT_V(8); PG8_WAIT_L(0); PG8_BAR; PG8_MMA(1, 0, At, B0); PG8_MMA(1, 1, At, B1); PG8_BAR; PG8_SCHED;
            PG8_LDB(B0, 1, 0); PG8_LDB(B1, 1, 1); PG8_SCHED; PG8_LDA(At, 1, 0); PG8_STAGE(PG8_SA(0, 1), a2 + hstepA, voffA);
            PG8_WAIT_V(8); PG8_WAIT_L(0); PG8_BAR; PG8_MMA(0, 0, At, B0); PG8_MMA(0, 1, At, B1); PG8_BAR; PG8_SCHED;
            PG8_LDA(At, 1, 1); PG8_STAGE(PG8_SB(1, 0), b3, voffB); PG8_STAGE(PG8_SB(1, 1), b3 + hstep, voffB); PG8_STAGE(PG8_SA(1, 0), a3, voffA);
            PG8_WAIT_V(8); PG8_WAIT_L(0); PG8_BAR; PG8_MMA(1, 0, At, B0); PG8_MMA(1, 1, At, B1); PG8_BAR; PG8_SCHED;
            } else {
            PG8_LDB(B0, 0, 0); PG8_SCHED; PG8_LDA(At, 0, 0); PG8_STAGE(PG8_SA(1, 1), a1 + hstepA, voffA);
            PG8_WAIT_L(8); PG8_BAR; PG8_WAIT_L(0); PG8_MMA(0, 0, At, B0); PG8_BAR; PG8_SCHED;
            PG8_LDB(B1, 0, 1); PG8_STAGE(PG8_SB(0, 0), b2, voffB);
            PG8_BAR; PG8_WAIT_L(0); PG8_MMA(0, 1, At, B1); PG8_BAR;
            PG8_LDA(At, 0, 1); PG8_STAGE(PG8_SA(0, 0), a2, voffA);
            PG8_BAR; PG8_WAIT_L(0); PG8_MMA(1, 0, At, B0); PG8_BAR; PG8_SCHED;
            PG8_STAGE(PG8_SB(0, 1), b2 + hstep, voffB);
            PG8_WAIT_V(6); PG8_BAR; PG8_MMA(1, 1, At, B1); PG8_BAR;
            PG8_LDB(B0, 1, 0); PG8_SCHED; PG8_LDA(At, 1, 0); PG8_STAGE(PG8_SA(0, 1), a2 + hstepA, voffA);
            PG8_WAIT_L(8); PG8_BAR; PG8_WAIT_L(0); PG8_MMA(0, 0, At, B0); PG8_BAR; PG8_SCHED;
            PG8_LDB(B1, 1, 1); PG8_STAGE(PG8_SB(1, 0), b3, voffB);
            PG8_BAR; PG8_WAIT_L(0); PG8_MMA(0, 1, At, B1); PG8_BAR;
            PG8_LDA(At, 1, 1); PG8_STAGE(PG8_SA(1, 0), a3, voffA);
            PG8_BAR; PG8_WAIT_L(0); PG8_MMA(1, 0, At, B0); PG8_BAR; PG8_SCHED;
            PG8_STAGE(PG8_SB(1, 1), b3 + hstep, voffB);
            PG8_WAIT_V(6); PG8_BAR; PG8_MMA(1, 1, At, B1); PG8_BAR;
            }
        }
        if constexpr (ALIGN_EPI) { if (wr == 0) PG8_BAR; }
        if constexpr (!Epi::AFTER_DRAIN) { E(acc, cur, wr, wc, fr, fq); S.done(cur); }
        if (!has_next) break;
#pragma unroll
        for (int a = 0; a < 2; ++a)
#pragma unroll
            for (int b = 0; b < 2; ++b)
#pragma unroll
                for (int m = 0; m < 4; ++m)
#pragma unroll
                    for (int n = 0; n < 2; ++n) acc[a][b][m][n] = (f32x4){0.f, 0.f, 0.f, 0.f};
        cur = nxt; cA = nA; cB = nB; ++ui;
        if constexpr (ALIGN_EPI) { if (wr == 1) PG8_BAR; }
    }
    PG8_WAIT_V(0);
    if constexpr (!ALIGN_EPI) { if (wr == 0) PG8_BAR; }
    PG8_BAR;
    if constexpr (Epi::AFTER_DRAIN) { E.fused(acc, cur, wr, wc, fr, fq, lds, wid, lane); S.done(cur); }
#undef PG8_SA
#undef PG8_SB
#undef PG8_STAGE
#undef PG8_LDA
#undef PG8_LDB
#undef PG8_MMA
#undef PG8_WAIT_V
#undef PG8_WAIT_L
#undef PG8_BAR
#undef PG8_SCHED
}
}

constexpr int NWAVES = 8, NTHR = 512;
constexpr int NB = 8, NT = 2048, DM = 1024, M = NB * NT, NL = 4;
constexpr int RW = 512, NH = 8, INW = 2816, NP = 3328, FF = 2816, NGU = 2 * FF;
constexpr int C_R = 0, C_K = 512, C_V = 1024, C_SCB = 1536, C_SCC = 1792, C_SCU = 2048, C_CFV = 2304, C_CFG = 2560;
constexpr int C_PW = 2816, C_PA = 2880, C_QW = 2944, C_QA = 3008, C_PG = 3072, C_QG = 3200;
constexpr int NP1 = 3072;
constexpr float NORM_EPS = 1e-6f, LN_EPS = 1e-5f, GN_EPS = 64e-5f;

enum { I_X = 0, I_WIN, I_MURKV, I_MUWAG, I_W0, I_W1, I_W2, I_A0, I_A1, I_A2, I_G1, I_G2, I_KK, I_KA, I_RK, I_LNXG, I_LNXB, I_SCW, I_CFW, I_CFB, I_CFLG, I_CFLB,
       I_WO, I_WGATE, I_WUP, I_WDOWN, I_PREMIX, I_POSTMIX, I_PREFFN, I_POSTFFN, N_IN };

constexpr size_t MiB = 1u << 20;
constexpr size_t WS_CTL = 0, CTL_ZERO_BYTES = 1024 * 1024, WS_SLOT1 = 512 * 1024, WS_SLOT2 = 768 * 1024;
static_assert(WS_SLOT2 + (size_t)16384 * 4 * 4 <= 1024 * 1024, "slots fit");
constexpr int CW_SEAM = 16384, SEAM_BANK = 64 * 64;
constexpr size_t WS_WIN = 1 * MiB + 256 * 1024;
constexpr size_t WS_WO = 8 * MiB;
constexpr size_t WS_WGU = 10 * MiB;
constexpr size_t WS_WDN = 21 * MiB;
static_assert(WS_WIN + (size_t)NP * DM * 2 <= WS_WO && WS_WO + (size_t)DM * DM * 2 <= WS_WGU && WS_WGU + (size_t)NGU * DM * 2 <= WS_WDN, "weights do not overlap");
constexpr size_t WS_SLOT3 = 26 * MiB + 512 * 1024;
constexpr size_t WS_HA = 27 * MiB;
constexpr size_t WS_HB = 59 * MiB;
constexpr size_t WS_PROJ = 91 * MiB + 256 * 1024;
constexpr size_t WS_X1 = WS_PROJ + 104 * MiB;
constexpr size_t WS_BON = 259 * MiB + 512 * 1024;
constexpr size_t XPAD = 80 * 1024 + 256;
static_assert(WS_X1 + 64 * MiB + 3 * XPAD <= WS_BON, "scan operands fit");
constexpr size_t WS_XA = 260 * MiB, WS_XB = WS_XA + 512 * 1024;
constexpr size_t WS_END = 261 * MiB;
static_assert(WS_WDN + (size_t)DM * FF * 2 <= WS_SLOT3 && WS_SLOT3 + (size_t)M * 16 <= WS_HA, "weights fit");
static_assert(WS_PROJ + (size_t)M * NP * 2 <= WS_X1, "proj fits");

#define GAS __attribute__((address_space(1)))
#define LAS __attribute__((address_space(3)))
typedef unsigned short bf16;
typedef unsigned v4u __attribute__((ext_vector_type(4)));
typedef unsigned v2u __attribute__((ext_vector_type(2)));
typedef float f32x4 __attribute__((ext_vector_type(4)));
typedef GAS unsigned gu32;
#define LDS_WAIT() asm volatile("s_waitcnt lgkmcnt(0)" ::: "memory")
#define LDS_BARRIER() do { asm volatile("s_waitcnt lgkmcnt(0)" ::: "memory"); __builtin_amdgcn_s_barrier(); asm volatile("" ::: "memory"); } while (0)

__device__ __forceinline__ unsigned f2bf(float f) { unsigned u = __builtin_bit_cast(unsigned, f); return (u + 0x7fffu + ((u >> 16) & 1u)) >> 16; }
typedef float f32x2c __attribute__((ext_vector_type(2)));
typedef __bf16 bf16x2c __attribute__((ext_vector_type(2)));
__device__ __forceinline__ unsigned cvtpk(float lo, float hi) { const f32x2c v = {lo, hi}; return __builtin_bit_cast(unsigned, __builtin_convertvector(v, bf16x2c)); }
__device__ __forceinline__ unsigned short bfr(float x) { return (unsigned short)cvtpk(x, 0.f); }
__device__ __forceinline__ unsigned pk2(float lo, float hi) { return f2bf(lo) | (f2bf(hi) << 16); }
__device__ __forceinline__ float bf2f(unsigned short u) { return __builtin_bit_cast(float, (unsigned)u << 16); }
__device__ __forceinline__ float bflo(unsigned u) { return __builtin_bit_cast(float, u << 16); }
__device__ __forceinline__ float bfhi(unsigned u) { return __builtin_bit_cast(float, u & 0xffff0000u); }
__device__ __forceinline__ float sigmoidf_(float x) { return 1.0f / (1.0f + __expf(-x)); }

template <int CTRL> __device__ __forceinline__ float dpp_mov(float x) { return __builtin_bit_cast(float, __builtin_amdgcn_update_dpp(0, __builtin_bit_cast(int, x), CTRL, 0xf, 0xf, true)); }
__device__ __forceinline__ float allreduce16(float x) {
    x += dpp_mov<0xB1>(x);
    x += dpp_mov<0x4E>(x);
    x += dpp_mov<0x141>(x);
    x += dpp_mov<0x140>(x);
    return x;
}

__device__ __forceinline__ float rdlane(float x, int lane) { return __builtin_bit_cast(float, __builtin_amdgcn_readlane(__builtin_bit_cast(int, x), lane)); }
__device__ __forceinline__ float wave_allsum(float x) {
    x = allreduce16(x);
    return (rdlane(x, 0) + rdlane(x, 16)) + (rdlane(x, 32) + rdlane(x, 48));
}
__device__ __forceinline__ float wave_sum(float v) { return wave_allsum(v); }
typedef float f32x2v __attribute__((ext_vector_type(2)));
__device__ __forceinline__ float half_allsum(float x) {
    x = allreduce16(x); const unsigned u = __float_as_uint(x); const auto r = __builtin_amdgcn_permlane16_swap(u, u, false, false); return __uint_as_float(r[0]) + __uint_as_float(r[1]);
}
__device__ __forceinline__ f32x2v bfpair(unsigned u) { return (f32x2v){__builtin_bit_cast(float, u << 16), __builtin_bit_cast(float, u & 0xffff0000u)}; }
typedef short bf16x8 __attribute__((ext_vector_type(8)));
typedef float f32x16 __attribute__((ext_vector_type(16)));
#define MFMA32(a, b, c) __builtin_amdgcn_mfma_f32_32x32x16_bf16((a), (b), (c), 0, 0, 0)
__device__ __forceinline__ int crow(int reg, int hh) { return (reg & 3) + 8 * (reg >> 2) + 4 * hh; }
__device__ __forceinline__ float tanh_fast(float x) { return 1.0f - 2.0f * __builtin_amdgcn_rcpf(1.0f + __expf(2.0f * x)); }
__device__ __forceinline__ float sigm_fast(float x) { return __builtin_amdgcn_rcpf(1.0f + __expf(-x)); }

#define XB_TMO      128
#define XB_XCNT(j)  (256  + 64 * (j))
#define XB_XSUB(j)  (1280 + 64 * (j))
#define XB_XGEN(j)  (2304 + 64 * (j))
#define XB_TOP      3328
#define XB_TOPGEN   3392
#define XCD_BAR_WORDS 3456
#define XB_SPIN_CAP (1u << 18)
__device__ __forceinline__ unsigned xb_ld(unsigned* p)              { return __hip_atomic_load(p, __ATOMIC_RELAXED, __HIP_MEMORY_SCOPE_AGENT); }
__device__ __forceinline__ unsigned xb_add(unsigned* p, unsigned v) { return __hip_atomic_fetch_add(p, v, __ATOMIC_RELAXED, __HIP_MEMORY_SCOPE_AGENT); }
__device__ __forceinline__ unsigned xb_xcc_id() { return (unsigned)__builtin_amdgcn_s_getreg((3 << 11) | 20) & 0xFu; }
#define XB_SPIN(cond, bar) do { unsigned _sp = 0; while (cond) { __builtin_amdgcn_s_sleep(1); \
    if ((++_sp & 255u) == 0u) { if (xb_ld(&(bar)[XB_TMO])) break; if (_sp > XB_SPIN_CAP) { atomicAdd(&(bar)[XB_TMO], 1u); break; } } } } while (0)
struct XcdBarrier { unsigned* bar; unsigned x; volatile LAS unsigned* st; };
__device__ __forceinline__ XcdBarrier xcd_barrier_post(unsigned* bar, volatile LAS unsigned* st) {
    XcdBarrier b; b.bar = bar; b.x = xb_xcc_id(); b.st = st;
    if (threadIdx.x == 0) (void)xb_add(&bar[XB_XCNT(b.x)], 1u);
    return b;
}
__device__ __forceinline__ void xcd_barrier_complete(unsigned* bar, unsigned x, unsigned& nloc, unsigned& nx) {
    const unsigned G = gridDim.x * gridDim.y * gridDim.z;
    unsigned sum, cnt, mine, sp = 0u;
    for (;;) {
        sum = 0u; cnt = 0u; mine = 0u;
#pragma unroll
        for (unsigned j = 0; j < 16; ++j) { const unsigned c = xb_ld(&bar[XB_XCNT(j)]); sum += c; cnt += (c > 0u) ? 1u : 0u; mine = (j == x) ? c : mine; }
        if (sum == G) break;
        __builtin_amdgcn_s_sleep(1);
        if ((++sp & 255u) == 0u) { if (xb_ld(&bar[XB_TMO])) break; if (sp > XB_SPIN_CAP) { atomicAdd(&bar[XB_TMO], 1u); break; } }
    }
    nloc = mine > 0u ? mine : 1u; nx = cnt > 0u ? cnt : 1u;
}
__device__ __forceinline__ void xcd_barrier(const XcdBarrier& b) {
    asm volatile("s_waitcnt vmcnt(0)" ::: "memory");
    __syncthreads();
    if (threadIdx.x == 0) {
        unsigned* bar = b.bar;
        __builtin_amdgcn_s_waitcnt(0);
        unsigned nloc = b.st[0], nx = b.st[1];
        if (nloc == 0u) { xcd_barrier_complete(bar, b.x, nloc, nx); b.st[0] = nloc; b.st[1] = nx; }
        const unsigned old = xb_add(&bar[XB_XSUB(b.x)], 1u);
        const unsigned gen = old / nloc;
        if (old + 1u == (gen + 1u) * nloc) {
            __builtin_amdgcn_fence(__ATOMIC_RELEASE, "agent");
            asm volatile("s_waitcnt vmcnt(0)" ::: "memory");
            const unsigned og = xb_add(&bar[XB_TOP], 1u);
            const unsigned tg = og / nx;
            if (og + 1u == (tg + 1u) * nx) xb_add(&bar[XB_TOPGEN], 1u);
            else XB_SPIN(xb_ld(&bar[XB_TOPGEN]) == tg, bar);
            __builtin_amdgcn_fence(__ATOMIC_ACQUIRE, "agent");
            xb_add(&bar[XB_XGEN(b.x)], 1u);
            asm volatile("s_waitcnt vmcnt(0)" ::: "memory");
        } else {
            XB_SPIN(xb_ld(&bar[XB_XGEN(b.x)]) == gen, bar);
            __builtin_amdgcn_fence(__ATOMIC_ACQUIRE, "agent");
            asm volatile("s_waitcnt vmcnt(0)" ::: "memory");
        }
    }
    __syncthreads();
}

constexpr int CW_GRP = 81920, CW_NICE = CW_GRP + 512;
__device__ __forceinline__ void grp_barrier(const XcdBarrier& b, unsigned* ctlb, int blk) {
    asm volatile("s_waitcnt vmcnt(0)" ::: "memory");
    __syncthreads();
    if (threadIdx.x == 0) {
        unsigned* c = ctlb + CW_GRP + 64 * (blk & 7);
        const unsigned old = xb_add(c, 1u), target = ((old >> 5) + 1u) << 5;
        XB_SPIN(xb_ld(c) < target, b.bar);
        __builtin_amdgcn_fence(__ATOMIC_ACQUIRE, "agent");
        asm volatile("s_waitcnt vmcnt(0)" ::: "memory");
    }
    __syncthreads();
}

constexpr int RING_BYTES = 131072, MISC_OFF = RING_BYTES + 320, LDS_BYTES = 147456;

struct Args { const float* in[N_IN]; float* out; unsigned char* ws; int ph_lo, ph_hi; };

struct Frame {
    LAS unsigned char* lds;
    int tid, lane, wave, blk, G;
    const float* const* in; float* out; unsigned char* ws;
};

struct ConvItem { const float* W; const float* s; const float* g; bf16* WT; int K, N, dst_row0, k0, n0, mode; };
__device__ __forceinline__ void conv_load(const ConvItem& it, float (&v)[32], int lane) {
#pragma unroll
    for (int i = 0; i < 8; ++i) { const int kk = 8 * i + (lane >> 3);
        f32x4 x = __builtin_nontemporal_load((const GAS f32x4*)(it.W + (size_t)(it.k0 + kk) * it.N + it.n0 + 4 * (lane & 7)));
        if (it.mode) { const float sv = ((const GAS float*)it.s)[it.k0 + kk]; x = x * ((it.mode == 1) ? sv : (1.0f - sv)); }
        v[4 * i] = x.x; v[4 * i + 1] = x.y; v[4 * i + 2] = x.z; v[4 * i + 3] = x.w; }
}
__device__ __forceinline__ void conv_store(const ConvItem& it, const float (&v)[32], LAS float* scr, int lane) {
#pragma unroll
    for (int i = 0; i < 32; ++i) scr[(8 * (i >> 2) + (lane >> 3)) * 33 + 4 * (lane & 7) + (i & 3)] = v[i];
    LDS_WAIT(); asm volatile("" ::: "memory");
    const int c = lane & 7;
    f32x4 ga = {1.f, 1.f, 1.f, 1.f}, gb = ga;
    if (it.g) { ga = *(const GAS f32x4*)(it.g + it.k0 + 8 * c); gb = *(const GAS f32x4*)(it.g + it.k0 + 8 * c + 4); }
#pragma unroll
    for (int j = 0; j < 4; ++j) { const int n = (lane >> 3) + 8 * j; const LAS float* p = scr + (8 * c) * 33 + n;
        v4u o; o.x = pk2(p[0 * 33] * ga.x, p[1 * 33] * ga.y); o.y = pk2(p[2 * 33] * ga.z, p[3 * 33] * ga.w); o.z = pk2(p[4 * 33] * gb.x, p[5 * 33] * gb.y); o.w = pk2(p[6 * 33] * gb.z, p[7 * 33] * gb.w);
        *(GAS v4u*)(it.WT + (size_t)(it.dst_row0 + n) * it.K + it.k0 + 8 * c) = o; }
    LDS_WAIT(); asm volatile("" ::: "memory");
}
__device__ __forceinline__ ConvItem conv_decode(const Frame& F, int r, int lin, int lrest) {
    constexpr int I_IN = 16 * 88, I_LORA = 256, I_O = 16 * 32, I_G = 16 * 88;
    bf16* WIN = (bf16*)(F.ws + WS_WIN); bf16* WO = (bf16*)(F.ws + WS_WO); bf16* WGU = (bf16*)(F.ws + WS_WGU); bf16* WDN = (bf16*)(F.ws + WS_WDN);
    ConvItem it; it.s = nullptr; it.mode = 0; it.g = nullptr;
    const int l = r < I_IN + I_LORA ? lin : lrest;
    if (r < I_IN) { const int kb = r / 88, nb = r % 88; it.g = F.in[I_PREMIX] + (size_t)l * DM; it.W = F.in[I_WIN] + (size_t)l * DM * INW; it.K = DM; it.N = INW; it.WT = WIN; it.dst_row0 = 32 * nb; it.k0 = 64 * kb; it.n0 = 32 * nb;
        if (it.n0 >= C_SCC) { const int rel = it.n0 - C_SCC, grp = rel >> 9, which = (rel >> 8) & 1, idx = rel & 255;
            it.dst_row0 = C_SCC + grp * 512 + (idx >> 7) * 256 + which * 128 + (idx & 127); }
        return it; } r -= I_IN;
    if (r < I_LORA) {
        int sub, rr;
        if (r < 128) { sub = r / 32; rr = r % 32; } else { sub = 4 + (r - 128) / 64; rr = (r - 128) % 64; }
        const int which = sub >> 1, isq = sub & 1, Nn = (which == 2) ? 128 : 64, nblk = Nn / 32, kb = rr / nblk, nb = rr % nblk;
        it.W = (which == 0 ? F.in[I_W1] : which == 1 ? F.in[I_A1] : F.in[I_G1]) + (size_t)l * DM * Nn; it.K = DM; it.N = Nn; it.WT = WIN;
        it.dst_row0 = (which == 0 ? (isq ? C_QW : C_PW) : which == 1 ? (isq ? C_QA : C_PA) : (isq ? C_QG : C_PG)) + 32 * nb; it.k0 = 64 * kb; it.n0 = 32 * nb;
        it.s = F.in[I_MUWAG] + (size_t)l * 3 * DM + which * DM; it.mode = isq ? 1 : 2; it.g = F.in[I_PREMIX] + (size_t)l * DM; return it; } r -= I_LORA;
    if (r < I_O) { const int kb = r / 32, nb = r % 32; it.W = F.in[I_WO] + (size_t)l * DM * DM; it.K = DM; it.N = DM; it.WT = WO; it.dst_row0 = 32 * nb; it.k0 = 64 * kb; it.n0 = 32 * nb; return it; } r -= I_O;
    if (r < 2 * I_G) { const int up = r / I_G, q = r % I_G, kb = q / 88, nb = q % 88, n0 = 32 * nb; it.g = F.in[I_PREFFN] + (size_t)l * DM;
        it.W = (up ? F.in[I_WUP] : F.in[I_WGATE]) + (size_t)l * DM * FF; it.K = DM; it.N = FF; it.WT = WGU; it.dst_row0 = (n0 / 128) * 256 + (n0 % 128) + up * 128; it.k0 = 64 * kb; it.n0 = n0; return it; } r -= 2 * I_G;
    { const int kb = r / 32, nb = r % 32; it.W = F.in[I_WDOWN] + (size_t)l * FF * DM; it.K = FF; it.N = DM; it.WT = WDN; it.dst_row0 = 32 * nb; it.k0 = 64 * kb; it.n0 = 32 * nb; }
    return it;
}
__device__ __forceinline__ void conv_run(const Frame& F, int lin, int lrest, int r, const int NGW, const int it_hi);
constexpr int CONV_REST_LO = 16 * 88 + 256, CONV_REST_N = 16 * 32 + 2 * 16 * 88 + 44 * 32;
__device__ __forceinline__ void phase_conv(const Frame& F, int lin, int lrest) {
    const int gw = F.blk * NWAVES + F.wave, NGW = F.G * NWAVES;
    constexpr int I_IN = 16 * 88, I_LORA = 256, I_O = 16 * 32, I_G = 16 * 88, I_D = 44 * 32;
    constexpr int NITEMS = I_IN + I_LORA + I_O + 2 * I_G + I_D;
    const int it_lo = lin >= 0 ? 0 : I_IN + I_LORA, it_hi = lrest >= 0 ? NITEMS : I_IN + I_LORA;
    conv_run(F, lin, lrest, it_lo + gw, NGW, it_hi);
}
__device__ __forceinline__ void conv_run(const Frame& F, int lin, int lrest, int r, const int NGW, const int it_hi) {
    LAS float* scr = (LAS float*)(F.lds + F.wave * 16384);
    if (r >= it_hi) return;
    ConvItem cur = conv_decode(F, r, lin, lrest); float v[32];
    conv_load(cur, v, F.lane);
    for (;;) {
        const int rn = r + NGW; const bool more = rn < it_hi;
        ConvItem nxt = cur; float vn[32];
        if (more) { nxt = conv_decode(F, rn, lin, lrest); conv_load(nxt, vn, F.lane); }
        conv_store(cur, v, scr, F.lane);
        if (!more) break;
        cur = nxt; r = rn;
#pragma unroll
        for (int i = 0; i < 32; ++i) v[i] = vn[i];
    }
}

__device__ __forceinline__ void store_row_bf16(bf16* orow, const f32x4 (&v)[4], float r, const float* g, int lane) {
    GAS unsigned long long* o8 = (GAS unsigned long long*)orow + lane;
#pragma unroll
    for (int j = 0; j < 4; ++j) { const f32x4 gg = *(const f32x4*)(g + 4 * lane + 256 * j);
        o8[64 * j] = (unsigned long long)pk2(v[j].x * r * gg.x, v[j].y * r * gg.y) | ((unsigned long long)pk2(v[j].z * r * gg.z, v[j].w * r * gg.w) << 32); }
}
__device__ __forceinline__ float row_sumsq(const f32x4 (&v)[4]) {
    float s = 0.f;
#pragma unroll
    for (int j = 0; j < 4; ++j) s += (v[j].x * v[j].x + v[j].y * v[j].y) + (v[j].z * v[j].z + v[j].w * v[j].w);
    return wave_sum(s);
}
__device__ __forceinline__ void phase_norm0(const Frame& F) {
    const int gw = F.blk * NWAVES + F.wave, NGW = F.G * NWAVES;
    bf16* X2 = (bf16*)(F.ws + WS_HA); GAS unsigned* SL = (GAS unsigned*)(F.ws + WS_SLOT3);
    for (int m = gw; m < M; m += 2 * NGW) {
        const int mb = m + NGW; const bool two = mb < M;
        const GAS f32x4* xr = (const GAS f32x4*)(F.in[I_X] + (size_t)m * DM) + F.lane;
        const GAS f32x4* xs = (const GAS f32x4*)(F.in[I_X] + (size_t)(two ? mb : m) * DM) + F.lane;
        f32x4 v[4], w[4];
#pragma unroll
        for (int j = 0; j < 4; ++j) v[j] = __builtin_nontemporal_load(xr + 64 * j);
#pragma unroll
        for (int j = 0; j < 4; ++j) w[j] = __builtin_nontemporal_load(xs + 64 * j);
        const float ss = row_sumsq(v), rn = rsqrtf(ss * (1.f / DM) + NORM_EPS);
        GAS unsigned long long* o8 = (GAS unsigned long long*)(X2 + (size_t)m * DM) + F.lane;
#pragma unroll
        for (int j = 0; j < 4; ++j) o8[64 * j] = (unsigned long long)pk2(v[j].x * rn, v[j].y * rn) | ((unsigned long long)pk2(v[j].z * rn, v[j].w * rn) << 32);
        if (F.lane < 4) SL[(size_t)m * 4 + F.lane] = F.lane == 0 ? (__float_as_uint(ss) & ~15u) : 0u;
        if (two) {
            const float s2 = row_sumsq(w), r2 = rsqrtf(s2 * (1.f / DM) + NORM_EPS);
            GAS unsigned long long* p8 = (GAS unsigned long long*)(X2 + (size_t)mb * DM) + F.lane;
#pragma unroll
            for (int j = 0; j < 4; ++j) p8[64 * j] = (unsigned long long)pk2(w[j].x * r2, w[j].y * r2) | ((unsigned long long)pk2(w[j].z * r2, w[j].w * r2) << 32);
            if (F.lane < 4) SL[(size_t)mb * 4 + F.lane] = F.lane == 0 ? (__float_as_uint(s2) & ~15u) : 0u;
        }
    }
}
__device__ __forceinline__ float* dca_ptr(const Frame& F, size_t chunk) { return chunk < 512 ? F.out + chunk * RW : (float*)(F.ws + WS_XA) + (chunk - 512) * RW; }
constexpr int LORA_OFF = 131072 + 1024, LORA_RS = 272;
template <int MODE> __device__ __forceinline__ void lora_stage(const Frame& F, const GAS bf16* PROJ, int m0, int colP, int colQ) {
    const int n_ = F.tid >> 4, j = F.tid & 15, tok = m0 + n_, t = tok % NT;
    const GAS bf16* pc = PROJ + (size_t)tok * NP + 8 * j;
    const v4u p = *(const GAS v4u*)(pc + colP); v4u q = *(const GAS v4u*)((t > 0 ? pc - NP : pc) + colQ);
    if (t == 0) q = (v4u){0u, 0u, 0u, 0u};
    v4u a;
#pragma unroll
    for (int e = 0; e < 4; ++e) { const float lo = bflo(p[e]) + bflo(q[e]), hi = bfhi(p[e]) + bfhi(q[e]);
        if (MODE == 0) a[e] = pk2(sigm_fast(lo), sigm_fast(hi));
        else a[e] = j < 8 ? pk2(tanh_fast(lo), tanh_fast(hi)) : pk2(lo, hi); }
    *(LAS v4u*)(F.lds + LORA_OFF + n_ * LORA_RS + 16 * j) = a;
}
__device__ __forceinline__ void phase_prep2(const Frame& F, int l) {
    const int hd = F.wave, lane = F.lane, n = lane & 31, hh = lane >> 5;
    LAS float* Tw = (LAS float*)(F.lds + F.wave * 16384); LAS float* Ta = Tw + 2048;
    const GAS bf16* PROJ = (const GAS bf16*)(F.ws + WS_PROJ);
    GAS bf16* AT = (GAS bf16*)(F.ws + WS_X1); GAS bf16* BT = (GAS bf16*)(F.ws + WS_X1 + 16 * MiB + XPAD); GAS bf16* KT = (GAS bf16*)(F.ws + WS_X1 + 32 * MiB + 2 * XPAD); GAS bf16* RT = (GAS bf16*)(F.ws + WS_X1 + 48 * MiB + 3 * XPAD);
    GAS bf16* VV = (GAS bf16*)(F.ws + WS_HB); GAS float* BON = (GAS float*)(F.ws + WS_BON);
    const int p = lane & 31, cp = hd * 64 + 2 * p;
    const f32x2v w0c = *(const GAS f32x2v*)(F.in[I_W0] + l * RW + cp), a0c = *(const GAS f32x2v*)(F.in[I_A0] + l * RW + cp), kkc = *(const GAS f32x2v*)(F.in[I_KK] + l * RW + cp),
                 kac = *(const GAS f32x2v*)(F.in[I_KA] + l * RW + cp), rkc = *(const GAS f32x2v*)(F.in[I_RK] + l * RW + cp);
    const f32x2v mur = *(const GAS f32x2v*)(F.in[I_MURKV] + l * 3 * RW + cp), muk = *(const GAS f32x2v*)(F.in[I_MURKV] + l * 3 * RW + RW + cp), muv = *(const GAS f32x2v*)(F.in[I_MURKV] + l * 3 * RW + 2 * RW + cp);
    bf16x8 Bw[4][2], Ba[4][2];
#pragma unroll
    for (int s = 0; s < 4; ++s)
#pragma unroll
        for (int nb = 0; nb < 2; ++nb)
#pragma unroll
            for (int j = 0; j < 8; ++j) { const size_t o = ((size_t)l * 64 + 16 * s + 8 * hh + j) * RW + hd * 64 + 32 * nb + n;
                Bw[s][nb][j] = (short)f2bf(F.in[I_W2][o]); Ba[s][nb][j] = (short)f2bf(F.in[I_A2][o]); }
    for (int tile_ = F.blk; tile_ < M / 64; tile_ += F.G) {
        const int tile = ((tile_ & 7) << 5) | (tile_ >> 3);
#pragma unroll 1
        for (int half = 0; half < 2; ++half) {
            const int m0 = tile * 64 + half * 32;
            const int tb = m0 + 16 * hh;
            unsigned pr_ = 0u, pk_ = 0u, pv_ = 0u;
            if ((tb % NT) != 0) { const GAS bf16* q = PROJ + (size_t)(tb - 1) * NP + cp; pr_ = *(const GAS unsigned*)(q + C_R); pk_ = *(const GAS unsigned*)(q + C_K); pv_ = *(const GAS unsigned*)(q + C_V); }
            unsigned rq[8], kq[8], vq[8];
#pragma unroll
            for (int j = 0; j < 8; ++j) { const GAS bf16* q = PROJ + (size_t)(tb + j) * NP + cp; rq[j] = __builtin_nontemporal_load((const GAS unsigned*)(q + C_R)); kq[j] = __builtin_nontemporal_load((const GAS unsigned*)(q + C_K)); vq[j] = __builtin_nontemporal_load((const GAS unsigned*)(q + C_V)); }
            {
                lora_stage<1>(F, PROJ, m0, C_PW, C_QW);
                LDS_BARRIER();
                bf16x8 Aw[4], Aa[4];
#pragma unroll
                for (int s = 0; s < 4; ++s) { Aw[s] = *(const LAS bf16x8*)(F.lds + LORA_OFF + n * LORA_RS + (16 * s + 8 * hh) * 2); Aa[s] = *(const LAS bf16x8*)(F.lds + LORA_OFF + n * LORA_RS + (64 + 16 * s + 8 * hh) * 2); }
                LDS_BARRIER();
                f32x16 accw[2], acca[2];
#pragma unroll
                for (int nb = 0; nb < 2; ++nb)
#pragma unroll
                    for (int r = 0; r < 16; ++r) { accw[nb][r] = 0.f; acca[nb][r] = 0.f; }
#pragma unroll
                for (int s = 0; s < 4; ++s) {
#pragma unroll
                    for (int nb = 0; nb < 2; ++nb) { accw[nb] = MFMA32(Aw[s], Bw[s][nb], accw[nb]); acca[nb] = MFMA32(Aa[s], Ba[s][nb], acca[nb]); }
                }
#pragma unroll
                for (int nb = 0; nb < 2; ++nb)
#pragma unroll
                    for (int r = 0; r < 16; ++r) { Tw[crow(r, hh) * 64 + 32 * nb + n] = accw[nb][r]; Ta[crow(r, hh) * 64 + 32 * nb + n] = acca[nb][r]; }
            }
            LDS_WAIT(); asm volatile("" ::: "memory");
            f32x2v rprev = bfpair(pr_), kprev = bfpair(pk_), vprev = bfpair(pv_), cum = {0.f, 0.f}, eprev = {1.f, 1.f};
#pragma unroll 1
            for (int ib = 0; ib < 16; ib += 8) {
                unsigned rn[8], kn[8], vn[8];
                if (ib + 8 < 16) {
#pragma unroll
                    for (int j = 0; j < 8; ++j) { const GAS bf16* q = PROJ + (size_t)(tb + ib + 8 + j) * NP + cp; rn[j] = __builtin_nontemporal_load((const GAS unsigned*)(q + C_R)); kn[j] = __builtin_nontemporal_load((const GAS unsigned*)(q + C_K)); vn[j] = __builtin_nontemporal_load((const GAS unsigned*)(q + C_V)); } }
#pragma unroll
                for (int j = 0; j < 8; ++j) {
                    const int i = ib + j, m = tb + i;
                    const f32x2v rp = bfpair(rq[j]), kp_ = bfpair(kq[j]), vp_ = bfpair(vq[j]);
                    const f32x2v wp = w0c + *(const LAS f32x2v*)(Tw + (16 * hh + i) * 64 + 2 * p), ap = a0c + *(const LAS f32x2v*)(Ta + (16 * hh + i) * 64 + 2 * p);
                    const f32x2v a = {sigm_fast(ap.x), sigm_fast(ap.y)}, lwv = (f32x2v){sigm_fast(wp.x), sigm_fast(wp.y)} * -0.60653065971f;
                    const f32x2v r = rp + (rprev - rp) * mur, k = kp_ + (kprev - kp_) * muk, v = vp_ + (vprev - vp_) * muv;
                    rprev = rp; kprev = kp_; vprev = vp_;
                    const f32x2v kku = k * kkc, kpr = k * (1.0f + (a - 1.0f) * kac), rk = r * kpr * rkc;
                    const float n2 = half_allsum(kku.x * kku.x + kku.y * kku.y), bon = half_allsum(rk.x + rk.y);
                    const f32x2v kk = kku * __builtin_amdgcn_rsqf(fmaxf(n2, 1e-24f)), bvv = kk * a;
                    cum += lwv;
                    const f32x2v ecur = {__expf(cum.x), __expf(cum.y)}, einv = {__builtin_amdgcn_rcpf(ecur.x), __builtin_amdgcn_rcpf(ecur.y)};
                    const size_t o = ((size_t)((m / NT) * NH + hd) * NT + (m % NT)) * 64 + 2 * p;
                    { const f32x2v x0 = kk * eprev, x1 = bvv * einv, x2 = kpr * einv, x3 = r * ecur;
                      *(GAS unsigned*)(AT + o) = cvtpk(-x0.x, -x0.y); *(GAS unsigned*)(BT + o) = cvtpk(x1.x, x1.y); *(GAS unsigned*)(KT + o) = cvtpk(x2.x, x2.y); *(GAS unsigned*)(RT + o) = cvtpk(x3.x, x3.y); *(GAS unsigned*)(VV + o) = cvtpk(v.x, v.y); }
                    eprev = ecur;
                    if (i == 15) *(GAS f32x2v*)((GAS float*)dca_ptr(F, (size_t)(m >> 4)) + cp) = ecur;
                    if (p == 0) BON[(size_t)m * NH + hd] = bon;
                }
                if (ib + 8 < 16) {
#pragma unroll
                    for (int j = 0; j < 8; ++j) { rq[j] = rn[j]; kq[j] = kn[j]; vq[j] = vn[j]; } }
            }
            LDS_WAIT(); asm volatile("" ::: "memory");
        }
    }
}
__device__ __forceinline__ void phase_post2(const Frame& F, int l) {
    const int hd = F.wave, lane = F.lane, n = lane & 31, hh = lane >> 5;
    LAS float* Tg = (LAS float*)(F.lds + F.wave * 16384);
    GAS bf16* PROJ = (GAS bf16*)(F.ws + WS_PROJ); const GAS bf16* Y = (const GAS bf16*)(F.ws + WS_HB + 16 * MiB + XPAD); const GAS bf16* VV = (const GAS bf16*)(F.ws + WS_HB); const GAS float* BON = (const GAS float*)(F.ws + WS_BON);
    const int p = lane & 31, cp = hd * 64 + 2 * p;
    const f32x2v lg_ = *(const GAS f32x2v*)(F.in[I_LNXG] + l * RW + cp), lb_ = *(const GAS f32x2v*)(F.in[I_LNXB] + l * RW + cp);
    int hhv = hd; asm volatile("" : "+v"(hhv));
    bf16x8 Bg[8][2];
#pragma unroll
    for (int s = 0; s < 8; ++s)
#pragma unroll
        for (int nb = 0; nb < 2; ++nb)
#pragma unroll
            for (int j = 0; j < 8; ++j) Bg[s][nb][j] = (short)f2bf(F.in[I_G2][((size_t)l * 128 + 16 * s + 8 * hh + j) * RW + hd * 64 + 32 * nb + n]);
    for (int tile_ = F.blk; tile_ < M / 64; tile_ += F.G) {
        const int tile = ((tile_ & 7) << 5) | (tile_ >> 3);
#pragma unroll 1
        for (int half = 0; half < 2; ++half) {
            const int m0 = tile * 64 + half * 32;
            const int tb = m0 + 16 * hh;
            unsigned vq[8], yq[8]; float bq[8];
#pragma unroll
            for (int j = 0; j < 8; ++j) { const size_t m = (size_t)(tb + j), oh = ((size_t)((m / NT) * NH + hd) * NT + (m % NT)) * 64 + 2 * p; vq[j] = __builtin_nontemporal_load((const GAS unsigned*)(VV + oh)); yq[j] = __builtin_nontemporal_load((const GAS unsigned*)(Y + oh)); bq[j] = BON[m * NH + hhv]; }
            {
                lora_stage<0>(F, PROJ, m0, C_PG, C_QG);
                LDS_BARRIER();
                bf16x8 Ag[8];
#pragma unroll
                for (int s = 0; s < 8; ++s) Ag[s] = *(const LAS bf16x8*)(F.lds + LORA_OFF + n * LORA_RS + (16 * s + 8 * hh) * 2);
                LDS_BARRIER();
                f32x16 accg[2];
#pragma unroll
                for (int nb = 0; nb < 2; ++nb)
#pragma unroll
                    for (int r = 0; r < 16; ++r) accg[nb][r] = 0.f;
#pragma unroll
                for (int s = 0; s < 8; ++s) {
#pragma unroll
                    for (int nb = 0; nb < 2; ++nb) accg[nb] = MFMA32(Ag[s], Bg[s][nb], accg[nb]);
                }
#pragma unroll
                for (int nb = 0; nb < 2; ++nb)
#pragma unroll
                    for (int r = 0; r < 16; ++r) Tg[crow(r, hh) * 64 + 32 * nb + n] = accg[nb][r];
            }
            LDS_WAIT(); asm volatile("" ::: "memory");
#pragma unroll 1
            for (int ib = 0; ib < 16; ib += 8) {
                unsigned vn[8], yn_[8]; float bn[8];
                if (ib + 8 < 16) {
#pragma unroll
                    for (int j = 0; j < 8; ++j) { const size_t m = (size_t)(tb + ib + 8 + j), oh = ((size_t)((m / NT) * NH + hd) * NT + (m % NT)) * 64 + 2 * p; vn[j] = __builtin_nontemporal_load((const GAS unsigned*)(VV + oh)); yn_[j] = __builtin_nontemporal_load((const GAS unsigned*)(Y + oh)); bn[j] = BON[m * NH + hhv]; } }
#pragma unroll
                for (int j = 0; j < 8; ++j) {
                    const int i = ib + j, m = tb + i;
                    const f32x2v v = bfpair(vq[j]), y = bfpair(yq[j]); const float bon = bq[j];
                    const f32x2v g = *(const LAS f32x2v*)(Tg + (16 * hh + i) * 64 + 2 * p);
                    const float mean = half_allsum(y.x + y.y) * (1.f / 64.f); const f32x2v d = y - mean; const float var = half_allsum(d.x * d.x + d.y * d.y) * (1.f / 64.f);
                    const f32x2v yn = (d * __builtin_amdgcn_rsqf(var + GN_EPS) * lg_ + lb_ + v * bon) * g;
                    *(GAS unsigned*)(PROJ + (size_t)m * NP + cp) = cvtpk(yn.x, yn.y);
                }
                if (ib + 8 < 16) {
#pragma unroll
                    for (int j = 0; j < 8; ++j) { vq[j] = vn[j]; yq[j] = yn_[j]; bq[j] = bn[j]; } }
            }
            LDS_WAIT(); asm volatile("" ::: "memory");
        }
    }
}
__device__ __forceinline__ void phase_sc2(const Frame& F, int l, const int m_lo, const int m_hi, const int m_step) {
    bf16* PROJ = (bf16*)(F.ws + WS_PROJ);
    const int g = F.tid & 31, sub = F.tid >> 5, c0 = 8 * g;
    float w0[8], w1[8], w2[8];
#pragma unroll
    for (int e = 0; e < 8; ++e) { w0[e] = F.in[I_SCW][(l * 3 + 0) * 256 + c0 + e]; w1[e] = F.in[I_SCW][(l * 3 + 1) * 256 + c0 + e]; w2[e] = F.in[I_SCW][(l * 3 + 2) * 256 + c0 + e]; }
    for (int m = m_lo + sub; m < m_hi; m += m_step) {
        const int t = m % NT; const bf16* p = PROJ + (size_t)m * NP + c0;
        const v4u B = *(const GAS v4u*)(p + C_SCB), P0 = *(const GAS v4u*)(p + C_SCC);
        const v4u P1 = *(const GAS v4u*)((t >= 1 ? p - NP : p) + C_SCC), P2 = *(const GAS v4u*)((t >= 2 ? p - 2 * NP : p) + C_SCC);
        const float z1 = t >= 1 ? 1.f : 0.f, z2 = t >= 2 ? 1.f : 0.f;
        v4u o;
#pragma unroll
        for (int e = 0; e < 4; ++e) {
            const float lo = bflo(B[e]) * (w2[2 * e] * bflo(P0[e]) + z1 * w1[2 * e] * bflo(P1[e]) + z2 * w0[2 * e] * bflo(P2[e]));
            const float hi = bfhi(B[e]) * (w2[2 * e + 1] * bfhi(P0[e]) + z1 * w1[2 * e + 1] * bfhi(P1[e]) + z2 * w0[2 * e + 1] * bfhi(P2[e]));
            o[e] = pk2(lo, hi); }
        *(GAS v4u*)(PROJ + (size_t)m * NP + 512 + c0) = o;
    }
}
__device__ __forceinline__ void phase_cf2(const Frame& F, int l, const int tile_lo, const int tile_hi) {
    bf16* PROJ = (bf16*)(F.ws + WS_PROJ);
    LAS float* U = (LAS float*)F.lds;
    LAS float* CT = (LAS float*)(F.lds + 94 * 256 * 4);
    const int c = F.tid & 255, half = F.tid >> 8;
    float wr[31];
#pragma unroll
    for (int k = 0; k < 31; ++k) wr[k] = F.in[I_CFW][((size_t)l * 31 + k) * 256 + c];
    const float cb = F.in[I_CFB][l * 256 + c];
    const f32x4 lng = *(const f32x4*)(F.in[I_CFLG] + l * 256 + 4 * F.lane), lnb = *(const f32x4*)(F.in[I_CFLB] + l * 256 + 4 * F.lane);
    for (int tile = tile_lo; tile < tile_hi; tile += 2) {
        const int m0 = tile * 32, t0 = m0 % NT;
        v4u vv[6];
#pragma unroll
        for (int q = 0; q < 6; ++q) { const int idx = F.tid + q * NTHR; const int rr = idx >> 5, g8 = (idx & 31) * 8; const int tt = t0 - 30 + rr;
            vv[q] = (v4u){0u, 0u, 0u, 0u};
            if (idx < 94 * 32 && tt >= 0) { const bf16* p = PROJ + (size_t)(m0 - 30 + rr) * NP + g8; vv[q] = *(const GAS v4u*)(p + C_CFV); } }
#pragma unroll
        for (int q = 0; q < 6; ++q) { const int idx = F.tid + q * NTHR; const int rr = idx >> 5, g8 = (idx & 31) * 8;
            if (idx < 94 * 32) { f32x4 u0, u1;
                u0.x = bflo(vv[q].x); u0.y = bfhi(vv[q].x); u0.z = bflo(vv[q].y); u0.w = bfhi(vv[q].y);
                u1.x = bflo(vv[q].z); u1.y = bfhi(vv[q].z); u1.z = bflo(vv[q].w); u1.w = bfhi(vv[q].w);
                *(LAS f32x4*)(U + rr * 256 + g8) = u0; *(LAS f32x4*)(U + rr * 256 + g8 + 4) = u1; } }
        __syncthreads();
#pragma unroll 1
        for (int hf = 0; hf < 2; ++hf) {
            { float acc[16];
#pragma unroll
              for (int i = 0; i < 16; ++i) acc[i] = cb;
#pragma unroll
              for (int r = 0; r < 46; ++r) { const float u = U[(hf * 32 + half * 16 + r) * 256 + c];
#pragma unroll
                  for (int i = 0; i < 16; ++i) if (r - i >= 0 && r - i <= 30) acc[i] += wr[r - i] * u; }
#pragma unroll
              for (int i = 0; i < 16; ++i) CT[(half * 16 + i) * 256 + c] = acc[i]; }
            __syncthreads();
#pragma unroll 1
            for (int q = 0; q < 4; ++q) { const int i = F.wave * 4 + q;
                const f32x4 x = *(const LAS f32x4*)(CT + i * 256 + 4 * F.lane);
                const float mean = wave_allsum((x.x + x.y) + (x.z + x.w)) * (1.f / 256.f);
                const f32x4 d = x - mean;
                const float var = wave_allsum((d.x * d.x + d.y * d.y) + (d.z * d.z + d.w * d.w)) * (1.f / 256.f);
                const float rs = rsqrtf(var + LN_EPS);
                f32x4 y = d * rs * lng + lnb;
                y.x = y.x * sigm_fast(y.x); y.y = y.y * sigm_fast(y.y); y.z = y.z * sigm_fast(y.z); y.w = y.w * sigm_fast(y.w);
                *(GAS unsigned long long*)(PROJ + (size_t)(m0 + hf * 32 + i) * NP + 768 + 4 * F.lane) = (unsigned long long)pk2(y.x, y.y) | ((unsigned long long)pk2(y.z, y.w) << 32); }
            __syncthreads();
        }
    }
}

typedef float f32x4v __attribute__((ext_vector_type(4)));
#define MFMA16(a, b, c) __builtin_amdgcn_mfma_f32_16x16x32_bf16((a), (b), (c), 0, 0, 0)
__device__ __forceinline__ bf16x8 op16(const f32x4v& t) { v4u o; o.x = cvtpk(t[0], t[1]); o.y = cvtpk(t[2], t[3]); o.z = 0u; o.w = 0u; return __builtin_bit_cast(bf16x8, o); }
#ifndef TIMING_PROBE
#define TIMING_PROBE 0
#endif
#if TIMING_PROBE
#define TP_BARRIER() do { const unsigned long long t0_ = __builtin_amdgcn_s_memtime(); LDS_BARRIER(); tp_bar += __builtin_amdgcn_s_memtime() - t0_; } while (0)
#else
#define TP_BARRIER() LDS_BARRIER()
#endif
__device__ __forceinline__ void phase_scan_ck(const Frame& F, int l, int probe = 0) {
#if TIMING_PROBE
    unsigned long long tp_bar = 0; const unsigned long long tp_t0 = __builtin_amdgcn_s_memtime();
#endif
    constexpr int RS = 144;
    constexpr int IMG = 16 * RS, O_AT = 0, O_RT = IMG, O_BT = 2 * IMG, O_KT = 3 * IMG, O_VT = 4 * IMG, O_TM = 5 * IMG, O_AAK = O_TM + 512, O_ARB = O_AAK + 512, O_ARK = O_ARB + 512, O_DC = O_ARK + 512, SLOT = O_DC + 256, NCH = NT / 16;
    static_assert(8 * SLOT <= RING_BYTES && SLOT % 16 == 0, "scan slots");
    const bf16* AT = (const bf16*)(F.ws + WS_X1); const bf16* BT = (const bf16*)(F.ws + WS_X1 + 16 * MiB + XPAD); const bf16* KT = (const bf16*)(F.ws + WS_X1 + 32 * MiB + 2 * XPAD); const bf16* RT = (const bf16*)(F.ws + WS_X1 + 48 * MiB + 3 * XPAD);
    const bf16* VV = (const bf16*)(F.ws + WS_HB); bf16* Y = (bf16*)(F.ws + WS_HB + 16 * MiB + XPAD);
    if (probe == 1 && F.wave < 2) { for (int grp = 0; grp < NT / 64; ++grp) LDS_BARRIER(); return; }
    if (probe == 2 && F.wave >= 4) { for (int grp = 0; grp < NT / 64; ++grp) LDS_BARRIER(); return; }
    const size_t ymask = probe == 2 ? (size_t)0x3ffff : ~(size_t)0; if (probe == 2) Y = (bf16*)(F.ws + WS_XB);
    const int b = F.blk & 7, h = F.blk >> 3, bh = b * 8 + h, ch = h * 64,     lane = F.lane, col = lane & 15, g = lane >> 4;
    const size_t mb = (size_t)b * NT;
    typedef unsigned long long u64;
    const f32x4v zero4 = {0.f, 0.f, 0.f, 0.f};
    if (F.wave >= 2 && F.wave < 4) { for (int grp = 0; grp < NCH / 4; ++grp) LDS_BARRIER(); return; }
    if (F.wave < 2) {
        const unsigned tra = (unsigned)((4 * g + ((lane & 15) >> 2)) * RS + (lane & 3) * 8);
        __builtin_amdgcn_s_setprio(3);
        f32x4v X[2][4];
#pragma unroll
        for (int j = 0; j < 2; ++j)
#pragma unroll
            for (int q = 0; q < 4; ++q) X[j][q] = zero4;
        for (int grp = 0; grp < NCH / 4; ++grp) {
            TP_BARRIER();
#pragma unroll 2
            for (int cc = 0; cc < 4; ++cc) {
                const LAS unsigned char* base = F.lds + ((grp & 1) * 4 + cc) * SLOT;
                const int t0 = (grp * 4 + cc) * 16;
                v4u aop[2], rop[2];
#pragma unroll
                for (int s = 0; s < 2; ++s) {
                    const u64 a0 = *(const LAS u64*)(base + O_AT + col * RS + (32 * s + 4 * g) * 2), a1 = *(const LAS u64*)(base + O_AT + col * RS + (32 * s + 16 + 4 * g) * 2);
                    const u64 r0 = *(const LAS u64*)(base + O_RT + col * RS + (32 * s + 4 * g) * 2), r1 = *(const LAS u64*)(base + O_RT + col * RS + (32 * s + 16 + 4 * g) * 2);
                    aop[s].x = (unsigned)a0; aop[s].y = (unsigned)(a0 >> 32); aop[s].z = (unsigned)a1; aop[s].w = (unsigned)(a1 >> 32); rop[s].x = (unsigned)r0; rop[s].y = (unsigned)(r0 >> 32); rop[s].z = (unsigned)r1; rop[s].w = (unsigned)(r1 >> 32); }
                const u64 ak8 = *(const LAS u64*)(base + O_AAK + col * 32 + 8 * g), tm = *(const LAS u64*)(base + O_TM + col * 32 + 8 * g);
                const u64 rb = *(const LAS u64*)(base + O_ARB + col * 32 + 8 * g), rk = *(const LAS u64*)(base + O_ARK + col * 32 + 8 * g);
                f32x4v dc[4];
#pragma unroll
                for (int q = 0; q < 4; ++q) dc[q] = *(const LAS f32x4v*)(base + O_DC + (16 * q + 4 * g) * 4);
                v2u tb0, tb1, tb2, tb3, tk0, tk1, tk2, tk3, tv0, tv1;
                { const unsigned a1 = (unsigned)(size_t)base + tra, a2 = a1 + O_VT + 64 * F.wave;
                  asm volatile("ds_read_b64_tr_b16 %0, %10 offset:%c12\n\tds_read_b64_tr_b16 %1, %10 offset:%c12+32\n\tds_read_b64_tr_b16 %2, %10 offset:%c12+64\n\tds_read_b64_tr_b16 %3, %10 offset:%c12+96\n\t"
                               "ds_read_b64_tr_b16 %4, %10 offset:%c13\n\tds_read_b64_tr_b16 %5, %10 offset:%c13+32\n\tds_read_b64_tr_b16 %6, %10 offset:%c13+64\n\tds_read_b64_tr_b16 %7, %10 offset:%c13+96\n\t"
                               "ds_read_b64_tr_b16 %8, %11\n\tds_read_b64_tr_b16 %9, %11 offset:32\n\ts_waitcnt lgkmcnt(0)"
                               : "=&v"(tb0), "=&v"(tb1), "=&v"(tb2), "=&v"(tb3), "=&v"(tk0), "=&v"(tk1), "=&v"(tk2), "=&v"(tk3), "=&v"(tv0), "=&v"(tv1) : "v"(a1), "v"(a2), "i"(O_BT), "i"(O_KT) : "memory"); }
                v4u bkop[4];
                bkop[0].x = tb0.x; bkop[0].y = tb0.y; bkop[0].z = tk0.x; bkop[0].w = tk0.y; bkop[1].x = tb1.x; bkop[1].y = tb1.y; bkop[1].z = tk1.x; bkop[1].w = tk1.y;
                bkop[2].x = tb2.x; bkop[2].y = tb2.y; bkop[2].z = tk2.x; bkop[2].w = tk2.y; bkop[3].x = tb3.x; bkop[3].y = tb3.y; bkop[3].z = tk3.x; bkop[3].w = tk3.y;
                v4u akop; akop.x = (unsigned)ak8; akop.y = (unsigned)(ak8 >> 32); akop.z = 0u; akop.w = 0u;
                v4u tmop; tmop.x = (unsigned)tm; tmop.y = (unsigned)(tm >> 32); tmop.z = 0u; tmop.w = 0u;
                v4u rbk; rbk.x = (unsigned)rb; rbk.y = (unsigned)(rb >> 32); rbk.z = (unsigned)rk; rbk.w = (unsigned)(rk >> 32);
#pragma unroll
                for (int j = 0; j < 2; ++j) {
                    const v2u tv = j ? tv1 : tv0;
                    v4u v16; v16.x = tv.x; v16.y = tv.y; v16.z = 0u; v16.w = 0u;
                    f32x4v acc = MFMA16(__builtin_bit_cast(bf16x8, akop), __builtin_bit_cast(bf16x8, v16), zero4);
                    v4u xb[2];
#pragma unroll
                    for (int s = 0; s < 2; ++s) { xb[s].x = cvtpk(X[j][2 * s][0], X[j][2 * s][1]); xb[s].y = cvtpk(X[j][2 * s][2], X[j][2 * s][3]); xb[s].z = cvtpk(X[j][2 * s + 1][0], X[j][2 * s + 1][1]); xb[s].w = cvtpk(X[j][2 * s + 1][2], X[j][2 * s + 1][3]); }
                    acc = MFMA16(__builtin_bit_cast(bf16x8, aop[0]), __builtin_bit_cast(bf16x8, xb[0]), acc);
                    acc = MFMA16(__builtin_bit_cast(bf16x8, aop[1]), __builtin_bit_cast(bf16x8, xb[1]), acc);
                    f32x4v accy = MFMA16(__builtin_bit_cast(bf16x8, rop[0]), __builtin_bit_cast(bf16x8, xb[0]), zero4);
                    accy = MFMA16(__builtin_bit_cast(bf16x8, rop[1]), __builtin_bit_cast(bf16x8, xb[1]), accy);
                    const f32x4v U = acc;
                    v4u uv; uv.x = cvtpk(U[0], U[1]); uv.y = cvtpk(U[2], U[3]); uv.z = tv.x; uv.w = tv.y;
#pragma unroll
                    for (int q = 0; q < 4; ++q) X[j][q] = MFMA16(__builtin_bit_cast(bf16x8, bkop[q]), __builtin_bit_cast(bf16x8, uv), X[j][q]) * dc[q];
                    accy = MFMA16(__builtin_bit_cast(bf16x8, rbk), __builtin_bit_cast(bf16x8, uv), accy);
                    { const unsigned y01 = cvtpk(accy[0], accy[1]), y23 = cvtpk(accy[2], accy[3]); bf16* yp = Y + ((((size_t)bh * NT + t0 + 4 * g) * 64 + 32 * F.wave + 16 * j + col) & ymask);
                      yp[0] = (bf16)y01; yp[64] = (bf16)(y01 >> 16); yp[128] = (bf16)y23; yp[192] = (bf16)(y23 >> 16); }
                }
            }
        }
        __builtin_amdgcn_s_setprio(0);
#if TIMING_PROBE == 1
        if (F.blk == 0 && F.wave == 0 && lane == 0 && l == 1) { float* tp = (float*)(F.ws + WS_CTL + 8192); tp[0] = (float)tp_bar; tp[1] = (float)(__builtin_amdgcn_s_memtime() - tp_t0); }
#endif
    } else {
        const int lw = F.wave - 4;
        __builtin_amdgcn_s_setprio(2);
        struct Ops { v4u at[2], rt[2], bt[2], kt[2], vv[2]; float dcv; };
        auto gload = [&](int grp, Ops& o) {
            const size_t m0 = mb + (size_t)(grp * 4 + lw) * 16, o0 = ((size_t)bh * NT + (size_t)(grp * 4 + lw) * 16 + col) * 64 + 8 * g;
            const bf16* pa = AT + o0; const bf16* pr = RT + o0; const bf16* pb = BT + o0; const bf16* pk = KT + o0; const bf16* pv = VV + o0; const float* pd = dca_ptr(F, m0 >> 4) + ch + lane;
            asm volatile("global_load_dwordx4 %0, %11, off\n\tglobal_load_dwordx4 %1, %11, off offset:64\n\tglobal_load_dwordx4 %2, %12, off\n\tglobal_load_dwordx4 %3, %12, off offset:64\n\t"
                         "global_load_dwordx4 %4, %13, off\n\tglobal_load_dwordx4 %5, %13, off offset:64\n\tglobal_load_dwordx4 %6, %14, off\n\tglobal_load_dwordx4 %7, %14, off offset:64\n\t"
                         "global_load_dwordx4 %8, %15, off\n\tglobal_load_dwordx4 %9, %15, off offset:64\n\tglobal_load_dword %10, %16, off"
                         : "=&v"(o.at[0]), "=&v"(o.at[1]), "=&v"(o.rt[0]), "=&v"(o.rt[1]), "=&v"(o.bt[0]), "=&v"(o.bt[1]), "=&v"(o.kt[0]), "=&v"(o.kt[1]), "=&v"(o.vv[0]), "=&v"(o.vv[1]), "=&v"(o.dcv)
                         : "v"(pa), "v"(pr), "v"(pb), "v"(pk), "v"(pv), "v"(pd) : "memory");
        };
        auto step = [&](Ops& u, int grp) {
            LAS unsigned char* base = F.lds + ((grp & 1) * 4 + lw) * SLOT;
            asm volatile("s_waitcnt vmcnt(22)" : "+v"(u.at[0]), "+v"(u.at[1]), "+v"(u.rt[0]), "+v"(u.rt[1]), "+v"(u.bt[0]), "+v"(u.bt[1]), "+v"(u.kt[0]), "+v"(u.kt[1]), "+v"(u.vv[0]), "+v"(u.vv[1]), "+v"(u.dcv) :: "memory");
            __builtin_amdgcn_sched_barrier(0);
            v4u (&at)[2] = u.at, (&rt)[2] = u.rt, (&bt)[2] = u.bt, (&kt)[2] = u.kt, (&vv)[2] = u.vv; const float dcv = u.dcv;
#pragma unroll
            for (int s = 0; s < 2; ++s) { const int o = col * RS + (32 * s + 8 * g) * 2;
                *(LAS v4u*)(base + O_AT + o) = at[s]; *(LAS v4u*)(base + O_RT + o) = rt[s]; *(LAS v4u*)(base + O_BT + o) = bt[s]; *(LAS v4u*)(base + O_KT + o) = kt[s]; *(LAS v4u*)(base + O_VT + o) = vv[s]; }
            *(LAS float*)(base + O_DC + lane * 4) = dcv;
            f32x4v L = zero4, LT = zero4, ak = zero4, rb = zero4, rk = zero4;
#pragma unroll
            for (int s = 0; s < 2; ++s) { const bf16x8 A_ = __builtin_bit_cast(bf16x8, at[s]), R_ = __builtin_bit_cast(bf16x8, rt[s]), B_ = __builtin_bit_cast(bf16x8, bt[s]), K_ = __builtin_bit_cast(bf16x8, kt[s]);
                L = MFMA16(A_, B_, L); LT = MFMA16(B_, A_, LT); ak = MFMA16(A_, K_, ak); rb = MFMA16(R_, B_, rb); rk = MFMA16(R_, K_, rk); }
            f32x4v I4;
#pragma unroll
            for (int r = 0; r < 4; ++r) { const int row = 4 * g + r; const bool lo = col < row, le = col <= row;
                L[r] = lo ? L[r] : 0.f; LT[r] = (row < col) ? LT[r] : 0.f; I4[r] = (row == col) ? 1.f : 0.f;
                *(LAS unsigned short*)(base + O_ARB + row * 32 + col * 2) = (unsigned short)(cvtpk(le ? rb[r] : 0.f, 0.f));
                *(LAS unsigned short*)(base + O_ARK + row * 32 + col * 2) = (unsigned short)(cvtpk(le ? rk[r] : 0.f, 0.f)); }
            const bf16x8 oL = op16(L), oLT = op16(LT);
            const f32x4v L2 = MFMA16(oLT, oL, zero4), L2T = MFMA16(oL, oLT, zero4);
            const bf16x8 oL2 = op16(L2), oL2T = op16(L2T);
            const f32x4v L4 = MFMA16(oL2T, oL2, zero4), L4T = MFMA16(oL2, oL2T, zero4);
            const f32x4v P1 = MFMA16(oLT, oL2, I4 + L + L2), P1T = MFMA16(oL2, oLT, I4 + LT + L2T);
            const bf16x8 oL4 = op16(L4), oL4T = op16(L4T), oP1T = op16(P1T);
            const f32x4v L8 = MFMA16(oL4T, oL4, zero4);
            const f32x4v P2 = MFMA16(oP1T, oL4, P1), P2T = MFMA16(oL4, oP1T, P1T);
            const f32x4v TmT = MFMA16(op16(L8), op16(P2T), P2T);
            const bf16x8 oT = op16(TmT);
            { v2u ta0, ta1, ta2, ta3;
              const unsigned a1 = (unsigned)(size_t)base + (unsigned)((4 * g + ((lane & 15) >> 2)) * RS + (lane & 3) * 8);
              asm volatile("s_waitcnt lgkmcnt(0)\n\tds_read_b64_tr_b16 %0, %4 offset:%c5\n\tds_read_b64_tr_b16 %1, %4 offset:%c5+32\n\tds_read_b64_tr_b16 %2, %4 offset:%c5+64\n\tds_read_b64_tr_b16 %3, %4 offset:%c5+96\n\ts_waitcnt lgkmcnt(0)"
                           : "=&v"(ta0), "=&v"(ta1), "=&v"(ta2), "=&v"(ta3) : "v"(a1), "i"(O_AT) : "memory");
              const v2u tas[4] = {ta0, ta1, ta2, ta3};
#pragma unroll
              for (int q = 0; q < 4; ++q) { v4u bo; bo.x = tas[q].x; bo.y = tas[q].y; bo.z = 0u; bo.w = 0u;
                  const f32x4v w1 = MFMA16(oT, __builtin_bit_cast(bf16x8, bo), zero4);
#pragma unroll
                  for (int r = 0; r < 4; ++r) *(LAS unsigned short*)(base + O_AT + (4 * g + r) * RS + (16 * q + col) * 2) = (unsigned short)(cvtpk(w1[r], 0.f)); } }
            { f32x4v akm;
#pragma unroll
              for (int r = 0; r < 4; ++r) akm[r] = (col < 4 * g + r) ? ak[r] : 0.f;
              const f32x4v ta = MFMA16(oT, op16(akm), zero4);
#pragma unroll
              for (int r = 0; r < 4; ++r) *(LAS unsigned short*)(base + O_AAK + (4 * g + r) * 32 + col * 2) = (unsigned short)(cvtpk(ta[r], 0.f)); }
            gload(grp + 3 < NCH / 4 ? grp + 3 : NCH / 4 - 1, u);
            TP_BARRIER();
        };
        Ops oa, ob, oc;
        gload(0, oa); gload(1, ob); gload(2, oc);
        for (int grp = 0; grp < NCH / 4; grp += 3) { step(oa, grp); if (grp + 1 < NCH / 4) step(ob, grp + 1); if (grp + 2 < NCH / 4) step(oc, grp + 2); }
        asm volatile("s_waitcnt vmcnt(0)" : "+v"(oa.dcv), "+v"(ob.dcv), "+v"(oc.dcv) :: "memory");
        __builtin_amdgcn_s_setprio(0);
#if TIMING_PROBE == 2
        if (F.blk == 0 && F.wave == 4 && lane == 0 && l == 1) { float* tp = (float*)(F.ws + WS_CTL + 8192); tp[0] = (float)tp_bar; tp[1] = (float)(__builtin_amdgcn_s_memtime() - tp_t0); }
#endif
    }
}
constexpr int CW_SIDE = 8192;
constexpr int SQ_GEMM = 40, SQ_CONV = CONV_REST_N / 16 / 8, SQ_CF = 32, SQ_SC = 16, SQ_N = SQ_GEMM + SQ_CONV + SQ_CF + SQ_SC;
static_assert(CONV_REST_N % 128 == 0 && SQ_N < 128, "queue layout");
__device__ __forceinline__ void phase_side(const Frame& F0, const int l0, volatile LAS unsigned* MISC, const int rep) {
    unsigned* const ctlb = (unsigned*)(F0.ws + WS_CTL);
    unsigned* const ctl = ctlb + CW_SIDE + l0 * 1024 + rep * 4096;
    unsigned ready = 0u, nxt = 0u;
    if (F0.tid == 0) { const unsigned q0 = xb_xcc_id() & 7u; MISC[17] = q0; nxt = xb_add(ctl + 64 * q0, 1u); }
    for (;;) {
        if (F0.tid == 0) { unsigned t = nxt, qs = MISC[17], q = qs & 255u, visited = qs >> 8; while (t >= (unsigned)SQ_N && MISC[18] == 0u && ++visited < 8u) { q = (q + 1u) & 7u; t = xb_add(ctl + 64 * q, 1u); }
                          MISC[17] = q | (visited << 8); MISC[16] = t < (unsigned)SQ_N ? q * 128u + t : 0xffffu; }
        __syncthreads();
        const unsigned code = (unsigned)__builtin_amdgcn_readfirstlane((int)MISC[16]);
        __syncthreads();
        if (code == 0xffffu) break;
        const int qq = (int)(code >> 7), i = (int)(code & 127u);
        int l_ = l0; asm volatile("" : "+v"(l_)); const int l = __builtin_amdgcn_readfirstlane(l_);
        Frame F = F0; { int t_ = threadIdx.x; asm volatile("" : "+v"(t_)); F.tid = t_; F.lane = t_ & 63; F.wave = __builtin_amdgcn_readfirstlane(t_ >> 6); }
        if (i < SQ_GEMM) {
            pg8::Gemm g{(const bf16*)(F.ws + WS_HA), (const bf16*)(F.ws + WS_WIN), M, NP, DM}; const int ct = i >> 3;
            pg8::OneUnit S{8 * qq + (i & 7), ct < 4 ? 7 + ct : NP1 / 256}; pg8::EpiSide E{(bf16*)(F.ws + WS_PROJ), NP, ct >= 4 ? 0 : ct < 2 ? 1 : 2, ct < 2 ? C_SCC + 128 * ct : C_CFV + 128 * (ct - 2)};
            pg8::gemm_phase<pg8::EpiSide, pg8::OneUnit, true, true>(F.lds, g, S, E);
            asm volatile("s_waitcnt vmcnt(0)" ::: "memory"); __syncthreads();
            if (threadIdx.x == 0) { if (i < 32) { if (MISC[18] == 0u) __builtin_amdgcn_fence(__ATOMIC_RELEASE, "agent");     asm volatile("s_waitcnt vmcnt(0)" ::: "memory"); xb_add(ctl + 512 + 64 * qq, 1u); }
                                    nxt = xb_add(ctl + 64 * qq, 1u); }
        } else {
            if (F.tid == 0) nxt = xb_add(ctl + 64 * qq, 1u);
            if (i < SQ_GEMM + SQ_CONV) {
                const int r0 = CONV_REST_LO + ((qq * SQ_CONV + (i - SQ_GEMM)) * 16);
                conv_run(F, -1, l, r0 + F.wave, NWAVES, r0 + 16);
            } else {
                if (!((ready >> qq) & 1u)) {
                    if (F.tid == 0) { XB_SPIN(xb_ld(ctl + 512 + 64 * qq) < 32u, ctlb + 4096); __builtin_amdgcn_fence(__ATOMIC_ACQUIRE, "agent"); asm volatile("s_waitcnt vmcnt(0)" ::: "memory"); }
                    __syncthreads(); ready |= 1u << qq; }
                if (i < SQ_GEMM + SQ_CONV + SQ_CF) { const int t0 = 64 * qq + 2 * (i - SQ_GEMM - SQ_CONV); phase_cf2(F, l, t0, t0 + 2); }
                else { const int m0 = NT * qq + 128 * (i - SQ_GEMM - SQ_CONV - SQ_CF); phase_sc2(F, l, m0, m0 + 128, 16); }
            }
        }
    }
}
#ifndef PH_MASK
#define PH_MASK 0x3ff
#endif
#define PH_ON(k) (((PH_MASK) >> (k)) & 1)
#ifndef PH_TWICE_K
#define PH_TWICE_K (-1)
#endif
#ifndef PROBE_SCAN_ONLY
#define PROBE_SCAN_ONLY 0
#endif
#ifndef PROBE_SCAN_MODE
#define PROBE_SCAN_MODE 0
#endif
#ifndef PROBE_SIDE_PART
#define PROBE_SIDE_PART 0
#endif
#ifndef PROBE_SIDE_ONLY
#define PROBE_SIDE_ONLY 0
#endif
constexpr int PH_PER_LAYER = 10, N_PHASES = NL * (PH_PER_LAYER + (PH_TWICE_K >= 0 ? 1 : 0));
__global__ void __launch_bounds__(NTHR, 2) fwd(Args args) {
    extern __shared__ __attribute__((aligned(16))) unsigned char lds_raw[];
    Frame F;
    F.lds = (LAS unsigned char*)lds_raw;
    F.tid = threadIdx.x; F.lane = F.tid & 63; F.wave = __builtin_amdgcn_readfirstlane(F.tid >> 6);
    F.blk = blockIdx.x; F.G = gridDim.x; F.in = args.in; F.out = args.out; F.ws = args.ws;
    volatile LAS unsigned* MISC = (volatile LAS unsigned*)(F.lds + MISC_OFF);
    if (F.tid < 32) MISC[F.tid] = 0u;
    __syncthreads();
    XcdBarrier bar; bar.bar = (unsigned*)(F.ws + WS_CTL) + 4096; bar.x = 0; bar.st = nullptr;
    const bool multi = (args.ph_hi - args.ph_lo) > 1;
    if (multi) { bar = xcd_barrier_post((unsigned*)(F.ws + WS_CTL) + 4096, MISC + 8);
                 if (threadIdx.x == 0 && (xb_xcc_id() != (blockIdx.x & 7u) || gridDim.x != 256u)) (void)xb_add((unsigned*)(F.ws + WS_CTL) + CW_NICE, 1u); }
    constexpr int TWK = PH_TWICE_K, PER = PH_PER_LAYER + (TWK >= 0 ? 1 : 0);
    for (int ph = args.ph_lo; ph < args.ph_hi; ++ph) {
        const int l = ph / PER, e = ph % PER, k = (TWK >= 0 && e > TWK) ? e - 1 : e; const int rep = (TWK >= 0 && e == TWK + 1) ? 1 : 0;
        {
        { int t_ = threadIdx.x; asm volatile("" : "+v"(t_)); F.tid = t_; F.lane = t_ & 63; F.wave = __builtin_amdgcn_readfirstlane(t_ >> 6);
          unsigned char* wp_ = args.ws; asm volatile("" : "+s"(wp_)); F.ws = wp_; int b_ = blockIdx.x; asm volatile("" : "+s"(b_)); F.blk = b_; }
        bf16* const WIN = (bf16*)(F.ws + WS_WIN); bf16* const WO = (bf16*)(F.ws + WS_WO); bf16* const WGU = (bf16*)(F.ws + WS_WGU); bf16* const WDN = (bf16*)(F.ws + WS_WDN);
        bf16* const HA = (bf16*)(F.ws + WS_X1); bf16* const X2 = (bf16*)(F.ws + WS_HA);     bf16* const PROJ = (bf16*)(F.ws + WS_PROJ);
        switch (k) {
        case 0: if (PH_ON(0)) { if (l == 0) { phase_conv(F, 0, -1); phase_norm0(F); } } break;
        case 1: if (PH_ON(1)) { pg8::Gemm g{X2, WIN, M, NP1, DM}; pg8::StaticOrder S; S.init(M, 8 * 256, F.G, F.blk); S.pn_from = 7; S.pn_to = 11; pg8::EpiBf16 E{PROJ, NP};
                  pg8::gemm_phase<pg8::EpiBf16, pg8::StaticOrder, true, true>(F.lds, g, S, E); } break;
        case 2: if (PH_ON(2)) phase_prep2(F, l); break;
        case 3: if (PH_ON(3)) { if (F.blk < NB * NH) { if (!(PROBE_SIDE_ONLY && rep)) phase_scan_ck(F, l, rep ? PROBE_SCAN_MODE : 0); }
                  else if (!(PROBE_SCAN_ONLY && rep)) phase_side(F, l, MISC, rep); } break;
        case 4: if (PH_ON(4)) phase_post2(F, l); break;
        case 5: if (PH_ON(5)) { pg8::Gemm g{PROJ, WO, M, DM, DM, NP};     pg8::StaticOrder S; S.init(M, DM, F.G, F.blk);
                  unsigned* ctl = (unsigned*)(F.ws + WS_CTL);
                  pg8::PanelSS s1{(unsigned*)(F.ws + WS_SLOT1), (unsigned)(2 * l + 1), ctl, 0x700u + 0x10u * l};
                  pg8::PanelSS s2{(unsigned*)(F.ws + WS_SLOT2), (unsigned)(2 * l + 1), ctl, 0x780u + 0x10u * l};
                  pg8::EpiRmsRes2 E{l < 0 ? F.in[I_X] : (const float*)X2, (float*)HA, F.in[I_POSTMIX] + l * DM, (const unsigned*)(F.ws + WS_SLOT3), s1, s2, NORM_EPS, 0};
                  pg8::gemm_phase<pg8::EpiRmsRes2, pg8::StaticOrder, false, true>(F.lds, g, S, E); } break;
        case 6: break;
        case 7: if (PH_ON(7)) { pg8::Gemm g{HA, WGU, M, NGU, DM}; pg8::StaticOrder S; S.init(M, NGU, F.G, F.blk); pg8::EpiSwiGLU E{PROJ, NP};
                  pg8::gemm_phase<pg8::EpiSwiGLU, pg8::StaticOrder, true, true>(F.lds, g, S, E);
                  if (l + 1 < NL && F.blk >= (NGU / 256 * (M / 256)) % F.G) { __syncthreads(); Frame F2 = F; F2.blk = F.blk - (NGU / 256 * (M / 256)) % F.G; F2.G = F.G - (NGU / 256 * (M / 256)) % F.G; phase_conv(F2, l + 1, -1); } } break;
        case 8: if (PH_ON(8)) { pg8::Gemm g{PROJ, WDN, M, DM, FF, NP}; pg8::StaticOrder S; S.init(M, DM, F.G, F.blk);
                  unsigned* ctl = (unsigned*)(F.ws + WS_CTL);
                  pg8::PanelSS s1{(unsigned*)(F.ws + WS_SLOT1), (unsigned)(2 * l + 2), ctl, 0x800u + 0x10u * l};
                  pg8::PanelSS s2{(unsigned*)(F.ws + WS_SLOT3), (unsigned)(2 * l + 2), ctl, 0x880u + 0x10u * l};
                  pg8::EpiRmsRes2 E{(const float*)HA, l + 1 < NL ? (float*)X2 : F.out, F.in[I_POSTFFN] + l * DM, (const unsigned*)(F.ws + WS_SLOT2), s1, s2, NORM_EPS, l + 1 < NL ? 0 : 1};
                  pg8::gemm_phase<pg8::EpiRmsRes2, pg8::StaticOrder, false, true>(F.lds, g, S, E); } break;
        case 9: break;
        }
        }
        if (ph + 1 < args.ph_hi && k != 6 && k != 9 && !(k == 0 && l > 0)) {
            if ((k == 1 || k == 2 || k == 4 || k == 5 || k == 7) && MISC[18] != 0u) grp_barrier(bar, (unsigned*)(F.ws + WS_CTL), blockIdx.x);
            else xcd_barrier(bar);
            if (ph == args.ph_lo) { if (threadIdx.x == 0) MISC[18] = xb_ld((unsigned*)(F.ws + WS_CTL) + CW_NICE) == 0u ? 1u : 0u; __syncthreads(); }
        }
        (void)rep;
    }
#if TIMING_PROBE
    xcd_barrier(bar);
    if (F.blk == 0 && threadIdx.x == 0) { const float* tp = (const float*)(F.ws + WS_CTL + 8192); const float frac = tp[0] / fmaxf(tp[1], 1.f);
        F.out[0] = 50.f + 100.f * frac; F.out[1] = -(50.f + tp[1] * (1.f / 2100.f) * 0.25f); }
#endif
}

#ifndef MK_ONE_LAUNCH
#define MK_ONE_LAUNCH 1
#endif
extern "C" void kernel_launch(void* const* d_in, const int* in_sizes, int n_in, void* d_out, int out_size, void* d_ws, size_t ws_size, hipStream_t stream) {
    static int grid = 0;
    if (grid == 0) {
        if (n_in != N_IN || in_sizes[0] != M * DM || out_size != M * DM || ws_size < WS_END) { fprintf(stderr, "kernel_launch: unexpected shapes (n_in %d, ws %zu)\n", n_in, ws_size); grid = -1; return; }
        int dev = 0, cus = 0, per_cu = 0;
        if (hipGetDevice(&dev) != hipSuccess || hipDeviceGetAttribute(&cus, hipDeviceAttributeMultiprocessorCount, dev) != hipSuccess) { grid = -1; return; }
        if (hipFuncSetAttribute((const void*)fwd, hipFuncAttributeMaxDynamicSharedMemorySize, LDS_BYTES) != hipSuccess) { fprintf(stderr, "kernel_launch: hipFuncSetAttribute failed\n"); grid = -1; return; }
        if (hipOccupancyMaxActiveBlocksPerMultiprocessor(&per_cu, (const void*)fwd, NTHR, LDS_BYTES) != hipSuccess || per_cu < 1) { fprintf(stderr, "kernel_launch: occupancy query says %d blocks per CU\n", per_cu); grid = -1; (void)hipGetLastError(); return; }
        grid = cus;
        if (grid != 256) { fprintf(stderr, "kernel_launch: built for a 256-CU device (one 256x256 unit per workgroup in the fused-norm GEMM phases), found %d CUs\n", cus); grid = -1; return; }
    }
    if (grid < 0) return;
    (void)hipMemsetAsync((char*)d_ws + WS_CTL, 0, CTL_ZERO_BYTES, stream);
    Args a{};
    for (int i = 0; i < N_IN; ++i) a.in[i] = (const float*)d_in[i];
    a.out = (float*)d_out; a.ws = (unsigned char*)d_ws;
#if MK_ONE_LAUNCH
    a.ph_lo = 0; a.ph_hi = N_PHASES;
    hipLaunchKernelGGL(fwd, dim3(grid), dim3(NTHR), LDS_BYTES, stream, a);
#else
    for (int ph = 0; ph < N_PHASES; ++ph) { a.ph_lo = ph; a.ph_hi = ph + 1; hipLaunchKernelGGL(fwd, dim3(grid), dim3(NTHR), LDS_BYTES, stream, a);
    }
#endif
}
```
